# Optimizing an MI355X kernel written in HIP

```python
import jax, jax.numpy as jnp
from jax import lax
import numpy as np

D_MODEL = 1024
BATCH = 4
SEQ = 4096
DEPTH = 1

GLA_HEADS = 4
GLA_DK = D_MODEL // 2
GLA_DV = D_MODEL
GLA_HEAD_K = GLA_DK // GLA_HEADS
GLA_HEAD_V = GLA_DV // GLA_HEADS
GATE_RANK = 16
GATE_TAU = 16.0
CHUNK = 64
CONV_WIDTH = D_MODEL
CONV_K = 3
D_FF = 4 * D_MODEL
EPS = 1e-6
N_MOD = 6

SPLITS = [GLA_DK, GLA_DK, GLA_DV, GLA_DV, GATE_RANK,
          CONV_WIDTH, CONV_WIDTH, CONV_WIDTH, D_MODEL, D_MODEL]
IN_WIDTH = sum(SPLITS)
SPLIT_IDX = [int(s) for s in np.cumsum(SPLITS)[:-1]]

kernel_name = "hybrid_gla_shortconv_adaln_block"


def rmsnorm(x, w):
    xf = x.astype(jnp.float32)
    y = xf * lax.rsqrt(jnp.mean(xf * xf, axis=-1, keepdims=True) + EPS)
    return (y * w.astype(jnp.float32)).astype(x.dtype)


def modulate(h, shift, scale):
    return h * (1.0 + scale[:, None, :]) + shift[:, None, :]


def gla_chunked(q, k, v, log_a):
    B, S, H, dk = q.shape
    dv = v.shape[-1]
    n = S // CHUNK

    def blk(t):
        return t.astype(jnp.float32).reshape(B, n, CHUNK, H, t.shape[-1]).transpose(0, 3, 1, 2, 4)

    q, k, v, la = blk(q), blk(k), blk(v), blk(log_a)
    b = jnp.cumsum(la, axis=3)
    b_last = b[:, :, :, -1:, :]
    q_dec = q * jnp.exp(b)
    k_dec = k * jnp.exp(-b)
    k_end = k * jnp.exp(b_last - b)
    causal = jnp.tril(jnp.ones((CHUNK, CHUNK), dtype=bool))
    scores = jnp.where(causal, jnp.einsum('bhncd,bhnsd->bhncs', q_dec, k_dec), 0.0)
    o_intra = jnp.einsum('bhncs,bhnsv->bhncv', scores, v)
    upd = jnp.einsum('bhncd,bhncv->bhndv', k_end, v)
    decay = jnp.exp(b_last[:, :, :, 0, :])

    def step(state, inp):
        d, u = inp
        return d[..., None] * state + u, state

    s0 = jnp.zeros((B, H, dk, dv), jnp.float32)
    _, s_prev = lax.scan(step, s0, (jnp.moveaxis(decay, 2, 0), jnp.moveaxis(upd, 2, 0)))
    s_prev = jnp.moveaxis(s_prev, 0, 2)
    o = o_intra + jnp.einsum('bhncd,bhndv->bhncv', q_dec, s_prev)
    return o.transpose(0, 2, 3, 1, 4).reshape(B, S, H, dv)


def causal_depthwise_conv(u, w):
    C = u.shape[-1]
    return lax.conv_general_dilated(
        u, w[:, None, :].astype(u.dtype), window_strides=(1,), padding=[(CONV_K - 1, 0)],
        dimension_numbers=('NWC', 'WIO', 'NWC'), feature_group_count=C)


def setup_inputs(seed: int = 0) -> dict:
    key = jax.random.key(seed)
    ks = jax.random.split(key, 20)
    L, D = DEPTH, D_MODEL
    nrm = lambda k, shape, s: jax.random.normal(k, shape, jnp.float32) * s
    return {
        "x": jax.random.normal(ks[0], (BATCH, SEQ, D), jnp.float32),
        "c": jax.random.normal(ks[1], (BATCH, D), jnp.float32),
        "w_ada": nrm(ks[2], (L, D, N_MOD * D), 0.2 * D ** -0.5),
        "b_ada": nrm(ks[3], (L, N_MOD * D), 0.02),
        "norm1_w": 1.0 + nrm(ks[4], (L, D), 0.02),
        "w_in": nrm(ks[5], (L, D, IN_WIDTH), D ** -0.5),
        "w_gate_up": nrm(ks[6], (L, GATE_RANK, GLA_DK), GATE_RANK ** -0.5),
        "b_gate": nrm(ks[7], (L, GLA_DK), 0.02),
        "gla_norm_w": 1.0 + nrm(ks[8], (L, GLA_HEAD_V), 0.02),
        "conv_w": nrm(ks[9], (L, CONV_K, CONV_WIDTH), CONV_K ** -0.5),
        "w_proj_a": nrm(ks[10], (L, GLA_DV, D), GLA_DV ** -0.5),
        "w_proj_b": nrm(ks[11], (L, CONV_WIDTH, D), CONV_WIDTH ** -0.5),
        "w_out": nrm(ks[12], (L, D, D), D ** -0.5),
        "norm2_w": 1.0 + nrm(ks[13], (L, D), 0.02),
        "w_mlp1": nrm(ks[14], (L, D, D_FF), D ** -0.5),
        "w_mlp2": nrm(ks[15], (L, D_FF, D), D_FF ** -0.5),
        "final_norm_w": 1.0 + nrm(ks[16], (D,), 0.02),
    }


def reference(x, c, w_ada, b_ada, norm1_w, w_in, w_gate_up, b_gate, gla_norm_w, conv_w,
              w_proj_a, w_proj_b, w_out, norm2_w, w_mlp1, w_mlp2, final_norm_w):
    B, S, D = x.shape
    c_act = jax.nn.silu(c)
    for l in range(DEPTH):
        mod = c_act @ w_ada[l] + b_ada[l]
        shift1, scale1, gate1, shift2, scale2, gate2 = jnp.split(mod, N_MOD, axis=-1)

        h = modulate(rmsnorm(x, norm1_w[l]), shift1, scale1)
        p = h @ w_in[l]
        q, k, v, g, lr, cb, cc, cx, ga, gb = jnp.split(p, SPLIT_IDX, axis=-1)

        log_a = jax.nn.log_sigmoid((lr @ w_gate_up[l] + b_gate[l]).astype(jnp.float32)) / GATE_TAU
        qh = q.reshape(B, S, GLA_HEADS, GLA_HEAD_K) * (GLA_HEAD_K ** -0.5)
        kh = k.reshape(B, S, GLA_HEADS, GLA_HEAD_K)
        vh = v.reshape(B, S, GLA_HEADS, GLA_HEAD_V)
        lah = log_a.reshape(B, S, GLA_HEADS, GLA_HEAD_K)
        o = gla_chunked(qh, kh, vh, lah)
        o = rmsnorm(o, gla_norm_w[l]).reshape(B, S, GLA_DV).astype(x.dtype)
        y_a = (o * jax.nn.silu(g)) @ w_proj_a[l]

        u = cc * cx
        y_b = (cb * causal_depthwise_conv(u, conv_w[l])) @ w_proj_b[l]

        z = jax.nn.sigmoid(ga) * y_a + jax.nn.sigmoid(gb) * y_b
        x = x + gate1[:, None, :] * (z @ w_out[l])

        h2 = modulate(rmsnorm(x, norm2_w[l]), shift2, scale2)
        m = jnp.square(jax.nn.relu(h2 @ w_mlp1[l])) @ w_mlp2[l]
        x = x + gate2[:, None, :] * m
    return rmsnorm(x, final_norm_w)
```

```cpp
#include <hip/hip_runtime.h>
#include <hip/hip_cooperative_groups.h>
#include <cstdio>
#include <cstdint>
namespace cg = cooperative_groups;

#define LAS __attribute__((address_space(3)))
typedef unsigned short bf16_t;
typedef short bf16x8 __attribute__((ext_vector_type(8)));
typedef float f32x4 __attribute__((ext_vector_type(4)));
typedef float f32x2 __attribute__((ext_vector_type(2)));
typedef unsigned u32x4 __attribute__((ext_vector_type(4)));
typedef unsigned u32x2 __attribute__((ext_vector_type(2)));

constexpr int BATCH = 4, SEQ = 4096, D = 1024, M = BATCH * SEQ, FF = 4096, INW = 8208, NMOD = 6 * D;
constexpr int LR_COL = 3072;
constexpr int REST_COL = 3088;
constexpr float EPS = 1e-6f;
constexpr int NWAVES = 8, NTHR = 512;

constexpr size_t MiB = 1u << 20;
constexpr size_t WS_CTL = 0, CTL_ZERO_BYTES = 1 * MiB;
constexpr size_t WS_MOD = 64 * 1024;
constexpr size_t WS_W1A = 2 * MiB;
constexpr size_t WS_W1B = 8 * MiB;
constexpr size_t WS_WAB = 18 * MiB;
constexpr size_t WS_WOUT = 22 * MiB;
constexpr size_t WS_WM1 = 24 * MiB;
constexpr size_t WS_WM2 = 32 * MiB;
constexpr size_t WS_LR = 40 * MiB;
constexpr size_t WS_DEC = 41 * MiB;
constexpr size_t WS_R = 48 * MiB;
constexpr size_t WS_KET = WS_R + 96 * MiB;
constexpr size_t WS_AAB = 176 * MiB;
constexpr size_t WS_END = 240 * MiB;

constexpr int LDS_BYTES = 147456;

__device__ __forceinline__ unsigned f2bf(float f) { unsigned u = __builtin_bit_cast(unsigned, f); return (u + 0x7fffu + ((u >> 16) & 1u)) >> 16; }
__device__ __forceinline__ unsigned pk2(float lo, float hi) { return f2bf(lo) | (f2bf(hi) << 16); }
__device__ __forceinline__ float bf2f(unsigned short v) { return __builtin_bit_cast(float, (unsigned)v << 16); }
__device__ __forceinline__ float bflo(unsigned w) { return __builtin_bit_cast(float, w << 16); }
__device__ __forceinline__ float bfhi(unsigned w) { return __builtin_bit_cast(float, w & 0xffff0000u); }
__device__ __forceinline__ float wave_sum(float v) {
#pragma unroll
    for (int o = 1; o < 64; o <<= 1) v += __shfl_xor(v, o);
    return v;
}
__device__ __forceinline__ float sigmoidf_(float v) { return 1.0f / (1.0f + __expf(-v)); }

namespace pg8 {
constexpr int BM = 256, BK = 64, HALF = 128, HTB = HALF * BK * 2, STAGE_BYTES = 8 * HTB, NXCD = 8, WGM = 8;
__host__ __device__ __forceinline__ int lds_byte(int r, int c) { const int st = (r >> 4) * 2 + (c >> 5), rr = r & 15, cc = c & 31, ob = rr * 64 + cc * 2; return st * 1024 + (ob ^ (((ob >> 9) & 1) << 5)); }
__host__ __device__ __forceinline__ void stage_rc(int b, int& R, int& C) { const int st = b / 1024, sb = b % 1024, swz = sb ^ (((sb >> 9) & 1) << 5); R = (st >> 1) * 16 + swz / 64; C = (st & 1) * 32 + (swz % 64) / 2; }
__host__ __device__ __forceinline__ int perm32(int rho) { const int n = rho >> 4, i = rho & 15; return 8 * (i >> 2) + 4 * n + (i & 3); }

struct Unit { int pm, pn; };
struct Gemm { const bf16_t* A; const bf16_t* Bt; int M, N, K, lda; };

struct StaticOrder {
    int nM, nN, nwg, G, c;
    __host__ __device__ void init(int M_, int N_, int G_, int c_) { nM = M_ / BM; nN = N_ / BM; nwg = nM * nN; G = G_; c = c_; }
    __host__ __device__ bool next(int i, Unit& u) const {
        const long L = (long)i * G + c; if (L >= nwg) return false;
        int wgid = (int)L; { const int q = nwg / NXCD, r = nwg % NXCD, xcd = wgid % NXCD, off = wgid / NXCD; wgid = (xcd < r ? xcd * (q + 1) : r * (q + 1) + (xcd - r) * q) + off; }
        const int nig = WGM * nN, gid = wgid / nig, fm = gid * WGM, gsz = (nM - fm) < WGM ? (nM - fm) : WGM;
        u.pm = fm + ((wgid % nig) % gsz); u.pn = (wgid % nig) / gsz; return true;
    }
};

__device__ __forceinline__ unsigned cvt_pk_bf16(float lo, float hi) { unsigned r; asm volatile("v_cvt_pk_bf16_f32 %0, %1, %2" : "=v"(r) : "v"(lo), "v"(hi)); return r; }

template <int ACT  > struct EpiBf16 {
    static constexpr bool PERM = true, HOOK = false;
    bf16_t* O; int ldc;
    __device__ __forceinline__ void hook(f32x4 (&)[2][2][4][2], const Unit&, int, int, int, int) const {}
    __device__ __forceinline__ void operator()(const f32x4 (&acc)[2][2][4][2], const Unit& u, int wr, int wc, int fr, int fq) const {
        int row0 = u.pm * BM + wr * 64 + fr; asm volatile("" : "+v"(row0)); const int col0 = u.pn * BM + wc * 32 + 8 * fq;
#pragma unroll
        for (int ai = 0; ai < 2; ++ai)
#pragma unroll
            for (int m = 0; m < 4; ++m) { bf16_t* rowp = O + (size_t)(row0 + ai * HALF + m * 16) * ldc + col0;
#pragma unroll
                for (int bj = 0; bj < 2; ++bj) { f32x4 v0 = acc[ai][bj][m][0], v1 = acc[ai][bj][m][1];
                    if (ACT == 1) {
#pragma unroll
                        for (int e = 0; e < 4; ++e) { float a0 = fmaxf(v0[e], 0.f), a1 = fmaxf(v1[e], 0.f); v0[e] = a0 * a0; v1[e] = a1 * a1; } }
                    u32x4 w; w.x = cvt_pk_bf16(v0[0], v0[1]); w.y = cvt_pk_bf16(v0[2], v0[3]); w.z = cvt_pk_bf16(v1[0], v1[1]); w.w = cvt_pk_bf16(v1[2], v1[3]);
                    *(u32x4*)(rowp + bj * HALF) = w; } }
    }
};
struct EpiG1b {
    static constexpr bool PERM = true, HOOK = false;
    bf16_t* O; int ldc;
    __device__ __forceinline__ void hook(f32x4 (&)[2][2][4][2], const Unit&, int, int, int, int) const {}
    __device__ __forceinline__ void operator()(const f32x4 (&acc)[2][2][4][2], const Unit& u, int wr, int wc, int fr, int fq) const {
        int row0 = u.pm * BM + wr * 64 + fr; asm volatile("" : "+v"(row0));
        if (u.pn >= 4 && u.pn < 12) {
            const int col0 = 1024 + (u.pn - 4) * 128 + wc * 32 + 8 * fq;
#pragma unroll
            for (int ai = 0; ai < 2; ++ai)
#pragma unroll
                for (int m = 0; m < 4; ++m) { bf16_t* rowp = O + (size_t)(row0 + ai * HALF + m * 16) * ldc + col0;
                    const f32x4 v0 = acc[ai][0][m][0] * acc[ai][1][m][0], v1 = acc[ai][0][m][1] * acc[ai][1][m][1];
                    u32x4 w; w.x = cvt_pk_bf16(v0[0], v0[1]); w.y = cvt_pk_bf16(v0[2], v0[3]); w.z = cvt_pk_bf16(v1[0], v1[1]); w.w = cvt_pk_bf16(v1[2], v1[3]);
                    *(u32x4*)rowp = w; }
        } else {
            const int colt = (u.pn < 4) ? u.pn * 256 : 2048 + (u.pn - 12) * 256; const int col0 = colt + wc * 32 + 8 * fq;
#pragma unroll
            for (int ai = 0; ai < 2; ++ai)
#pragma unroll
                for (int m = 0; m < 4; ++m) { bf16_t* rowp = O + (size_t)(row0 + ai * HALF + m * 16) * ldc + col0;
#pragma unroll
                    for (int bj = 0; bj < 2; ++bj) { const f32x4 v0 = acc[ai][bj][m][0], v1 = acc[ai][bj][m][1];
                        u32x4 w; w.x = cvt_pk_bf16(v0[0], v0[1]); w.y = cvt_pk_bf16(v0[2], v0[3]); w.z = cvt_pk_bf16(v1[0], v1[1]); w.w = cvt_pk_bf16(v1[2], v1[3]);
                        *(u32x4*)(rowp + bj * HALF) = w; } }
        }
    }
};
struct EpiZ {
    static constexpr bool PERM = true, HOOK = true;
    const bf16_t* GA; const bf16_t* GB; int ldg; bf16_t* Z; int ldz;
    __device__ __forceinline__ void hook(f32x4 (&acc)[2][2][4][2], const Unit& u, int wr, int wc, int fr, int fq) const {
        int row0 = u.pm * BM + wr * 64 + fr; asm volatile("" : "+v"(row0)); const int col0 = u.pn * BM + wc * 32 + 8 * fq;
#pragma unroll
        for (int ai = 0; ai < 2; ++ai)
#pragma unroll
            for (int m = 0; m < 4; ++m) { const size_t ro = (size_t)(row0 + ai * HALF + m * 16) * ldg + col0;
#pragma unroll
                for (int bj = 0; bj < 2; ++bj) { const u32x4 a = *(const u32x4*)(GA + ro + bj * HALF), b = *(const u32x4*)(GB + ro + bj * HALF);
#pragma unroll
                    for (int q = 0; q < 4; ++q) { const float ga0 = bflo(a[q]), ga1 = bfhi(a[q]), gb0 = bflo(b[q]), gb1 = bfhi(b[q]);
                        const float r0 = (1.0f + __expf(-gb0)) / (1.0f + __expf(-ga0)), r1 = (1.0f + __expf(-gb1)) / (1.0f + __expf(-ga1));
                        acc[ai][bj][m][q >> 1][(q & 1) * 2] *= r0; acc[ai][bj][m][q >> 1][(q & 1) * 2 + 1] *= r1; } }
                asm volatile("" ::: "memory"); }
    }
    __device__ __forceinline__ void operator()(const f32x4 (&acc)[2][2][4][2], const Unit& u, int wr, int wc, int fr, int fq) const {
        int row0 = u.pm * BM + wr * 64 + fr; asm volatile("" : "+v"(row0)); const int col0 = u.pn * BM + wc * 32 + 8 * fq;
#pragma unroll
        for (int ai = 0; ai < 2; ++ai)
#pragma unroll
            for (int m = 0; m < 4; ++m) { const size_t ro = (size_t)(row0 + ai * HALF + m * 16) * ldg + col0; bf16_t* zp = Z + (size_t)(row0 + ai * HALF + m * 16) * ldz + col0;
#pragma unroll
                for (int bj = 0; bj < 2; ++bj) { const u32x4 b = *(const u32x4*)(GB + ro + bj * HALF); u32x4 w;
#pragma unroll
                    for (int q = 0; q < 4; ++q) { const float s0 = sigmoidf_(bflo(b[q])), s1 = sigmoidf_(bfhi(b[q]));
                        w[q] = cvt_pk_bf16(acc[ai][bj][m][q >> 1][(q & 1) * 2] * s0, acc[ai][bj][m][q >> 1][(q & 1) * 2 + 1] * s1); }
                    *(u32x4*)(zp + bj * HALF) = w; }
                asm volatile("" ::: "memory"); }
    }
};
struct EpiRes {
    static constexpr bool PERM = false, HOOK = false;
    const float* base; float* out; int ldc; const float* gate;
    __device__ __forceinline__ void hook(f32x4 (&)[2][2][4][2], const Unit&, int, int, int, int) const {}
    __device__ __forceinline__ void operator()(const f32x4 (&acc)[2][2][4][2], const Unit& u, int wr, int wc, int fr, int fq) const {
        int row0 = u.pm * BM + wr * 64 + fr; asm volatile("" : "+v"(row0)); const int col0 = u.pn * BM + wc * 32 + 4 * fq; const int b = u.pm >> 4;
        f32x4 gv[2][2];
#pragma unroll
        for (int bj = 0; bj < 2; ++bj)
#pragma unroll
            for (int n = 0; n < 2; ++n) gv[bj][n] = *(const f32x4*)(gate + (size_t)b * NMOD + col0 + bj * HALF + n * 16);
#pragma unroll
        for (int ai = 0; ai < 2; ++ai)
#pragma unroll
            for (int m = 0; m < 4; ++m) { const size_t off = (size_t)(row0 + ai * HALF + m * 16) * ldc + col0;
#pragma unroll
                for (int bj = 0; bj < 2; ++bj)
#pragma unroll
                    for (int n = 0; n < 2; ++n) { const f32x4 bs = *(const f32x4*)(base + off + bj * HALF + n * 16);
                        *(f32x4*)(out + off + bj * HALF + n * 16) = bs + gv[bj][n] * acc[ai][bj][m][n]; } }
    }
};

template <class Epi, class Sched, bool ALIGN_EPI = false, bool SP2 = false>
__device__ __forceinline__ void gemm_phase(LAS unsigned char* lds, const Gemm g, const Sched& S, const Epi& E) {
    const int tid = threadIdx.x, wid = __builtin_amdgcn_readfirstlane(tid >> 6), lane = tid & 63, wr = wid >> 2, wc = wid & 3, fr = lane & 15, fq = lane >> 4;
    const int K = g.K, nt = K / BK, lda = g.lda;
    unsigned voffA[2], voffB[2];
#pragma unroll
    for (int i = 0; i < 2; ++i) { int R, C; stage_rc(tid * 16 + i * 8192, R, C); const int Rb = Epi::PERM ? ((R & ~31) + perm32(R & 31)) : R;
        voffA[i] = (unsigned)(R * lda + C) * 2u; voffB[i] = (unsigned)(Rb * K + C) * 2u; }
    const size_t kstep = (size_t)(BK * 2);
    const size_t hstepA = (size_t)HALF * lda * 2, hstepB = (size_t)HALF * K * 2;
    const size_t tstepA = 2 * hstepA, tstepB = 2 * hstepB;
    const unsigned ldsw = (unsigned)wid * 1024u;
    const int aoff = lds_byte(wr * 64 + fr, fq * 8), boff = lds_byte(wc * 32 + fr, fq * 8);
#define PG8_SA(b, h) (((b) * 2 + (h)) * HTB)
#define PG8_SB(b, h) ((4 + (b) * 2 + (h)) * HTB)
#define PG8_STAGE(bufoff, gbase, voff) do { _Pragma("unroll") for (int _i = 0; _i < 2; ++_i) \
        __builtin_amdgcn_global_load_lds((const unsigned*)((const char*)(gbase) + (voff)[_i]), (LAS unsigned*)(lds + (bufoff) + ldsw + _i * 8192), 16, 0, 0); } while (0)
#define PG8_LDA(dst, b, h) do { _Pragma("unroll") for (int m = 0; m < 4; ++m) _Pragma("unroll") for (int k = 0; k < 2; ++k) dst[m][k] = *(const LAS bf16x8*)(lds + PG8_SA(b, h) + aoff + m * 2048 + k * 1024); } while (0)
#define PG8_LDB(dst, b, h) do { _Pragma("unroll") for (int n = 0; n < 2; ++n) _Pragma("unroll") for (int k = 0; k < 2; ++k) dst[n][k] = *(const LAS bf16x8*)(lds + PG8_SB(b, h) + boff + n * 2048 + k * 1024); } while (0)
#define PG8_MMA(ai, bj, At, Bt) do { __builtin_amdgcn_s_setprio(1); _Pragma("unroll") for (int m = 0; m < 4; ++m) _Pragma("unroll") for (int n = 0; n < 2; ++n) _Pragma("unroll") for (int k = 0; k < 2; ++k) \
        acc[ai][bj][m][n] = __builtin_amdgcn_mfma_f32_16x16x32_bf16(Bt[n][k], At[m][k], acc[ai][bj][m][n], 0, 0, 0); __builtin_amdgcn_s_setprio(0); } while (0)
#define PG8_WAIT_V(n) asm volatile("s_waitcnt vmcnt(" #n ")" ::: "memory")
#define PG8_WAIT_L(n) asm volatile("s_waitcnt lgkmcnt(" #n ")" ::: "memory")
#define PG8_BAR __builtin_amdgcn_s_barrier()
#define PG8_SCHED __builtin_amdgcn_sched_barrier(0)
    Unit cur, nxt; int ui = 0;
    if (!S.next(0, cur)) return;
    f32x4 acc[2][2][4][2];
#pragma unroll
    for (int a = 0; a < 2; ++a)
#pragma unroll
        for (int b = 0; b < 2; ++b)
#pragma unroll
            for (int m = 0; m < 4; ++m)
#pragma unroll
                for (int n = 0; n < 2; ++n) acc[a][b][m][n] = (f32x4){0.f, 0.f, 0.f, 0.f};
    bf16x8 At[4][2], B0[2][2], B1[2][2];
    const char* cA = (const char*)g.A + (size_t)cur.pm * tstepA; const char* cB = (const char*)g.Bt + (size_t)cur.pn * tstepB;
    if constexpr (SP2) {
        PG8_STAGE(PG8_SB(0, 0), cB, voffB); PG8_STAGE(PG8_SB(0, 1), cB + hstepB, voffB); PG8_STAGE(PG8_SA(0, 0), cA, voffA); PG8_STAGE(PG8_SA(0, 1), cA + hstepA, voffA);
        if (wr == 1) PG8_BAR;
        PG8_WAIT_V(2); PG8_BAR;
        PG8_STAGE(PG8_SB(1, 0), cB + kstep, voffB); PG8_STAGE(PG8_SA(1, 0), cA + kstep, voffA); PG8_STAGE(PG8_SB(1, 1), cB + hstepB + kstep, voffB);
        PG8_WAIT_V(6); PG8_BAR;
    } else {
        PG8_STAGE(PG8_SB(0, 0), cB, voffB); PG8_STAGE(PG8_SA(0, 0), cA, voffA); PG8_STAGE(PG8_SB(0, 1), cB + hstepB, voffB); PG8_STAGE(PG8_SA(0, 1), cA + hstepA, voffA);
        if (wr == 1) PG8_BAR;
        PG8_WAIT_V(4); PG8_BAR;
        PG8_STAGE(PG8_SB(1, 0), cB + kstep, voffB); PG8_STAGE(PG8_SA(1, 0), cA + kstep, voffA); PG8_STAGE(PG8_SB(1, 1), cB + hstepB + kstep, voffB);
        PG8_WAIT_V(6); PG8_BAR;
    }
    for (;;) {
        const bool has_next = S.next(ui + 1, nxt);
        const char* nA = has_next ? (const char*)g.A + (size_t)nxt.pm * tstepA : cA; const char* nB = has_next ? (const char*)g.Bt + (size_t)nxt.pn * tstepB : cB;
        for (int t = 0; t < nt; t += 2) {
            const bool last = (t == nt - 2);
            const char* a1 = cA + (size_t)(t + 1) * kstep;
            const char* a2 = last ? nA : cA + (size_t)(t + 2) * kstep; const char* b2 = last ? nB : cB + (size_t)(t + 2) * kstep;
            const char* a3 = a2 + kstep; const char* b3 = b2 + kstep;
            if constexpr (Epi::HOOK) { if (t == (nt >> 1)) { E.hook(acc, cur, wr, wc, fr, fq); asm volatile("" ::: "memory"); } }
            if constexpr (SP2) {
            PG8_LDB(B0, 0, 0); PG8_LDB(B1, 0, 1); PG8_SCHED; PG8_LDA(At, 0, 0); PG8_STAGE(PG8_SA(1, 1), a1 + hstepA, voffA);
            PG8_WAIT_V(8); PG8_WAIT_L(0); PG8_BAR; PG8_MMA(0, 0, At, B0); PG8_MMA(0, 1, At, B1); PG8_BAR; PG8_SCHED;
            PG8_LDA(At, 0, 1); PG8_STAGE(PG8_SB(0, 0), b2, voffB); PG8_STAGE(PG8_SB(0, 1), b2 + hstepB, voffB); PG8_STAGE(PG8_SA(0, 0), a2, voffA);
            PG8_WAIT_V(8); PG8_WAIT_L(0); PG8_BAR; PG8_MMA(1, 0, At, B0); PG8_MMA(1, 1, At, B1); PG8_BAR; PG8_SCHED;
            PG8_LDB(B0, 1, 0); PG8_LDB(B1, 1, 1); PG8_SCHED; PG8_LDA(At, 1, 0); PG8_STAGE(PG8_SA(0, 1), a2 + hstepA, voffA);
            PG8_WAIT_V(8); PG8_WAIT_L(0); PG8_BAR; PG8_MMA(0, 0, At, B0); PG8_MMA(0, 1, At, B1); PG8_BAR; PG8_SCHED;
            PG8_LDA(At, 1, 1); PG8_STAGE(PG8_SB(1, 0), b3, voffB); PG8_STAGE(PG8_SB(1, 1), b3 + hstepB, voffB); PG8_STAGE(PG8_SA(1, 0), a3, voffA);
            PG8_WAIT_V(8); PG8_WAIT_L(0); PG8_BAR; PG8_MMA(1, 0, At, B0); PG8_MMA(1, 1, At, B1); PG8_BAR; PG8_SCHED;
            } else {
            PG8_LDB(B0, 0, 0); PG8_SCHED; PG8_LDA(At, 0, 0); PG8_STAGE(PG8_SA(1, 1), a1 + hstepA, voffA);
            PG8_WAIT_L(8); PG8_BAR; PG8_WAIT_L(0); PG8_MMA(0, 0, At, B0); PG8_BAR; PG8_SCHED;
            PG8_LDB(B1, 0, 1); PG8_STAGE(PG8_SB(0, 0), b2, voffB);
            PG8_BAR; PG8_WAIT_L(0); PG8_MMA(0, 1, At, B1); PG8_BAR;
            PG8_LDA(At, 0, 1); PG8_STAGE(PG8_SA(0, 0), a2, voffA);
            PG8_BAR; PG8_WAIT_L(0); PG8_MMA(1, 0, At, B0); PG8_BAR; PG8_SCHED;
            PG8_STAGE(PG8_SB(0, 1), b2 + hstepB, voffB);
            PG8_WAIT_V(6); PG8_BAR; PG8_MMA(1, 1, At, B1); PG8_BAR;
            PG8_LDB(B0, 1, 0); PG8_SCHED; PG8_LDA(At, 1, 0); PG8_STAGE(PG8_SA(0, 1), a2 + hstepA, voffA);
            PG8_WAIT_L(8); PG8_BAR; PG8_WAIT_L(0); PG8_MMA(0, 0, At, B0); PG8_BAR; PG8_SCHED;
            PG8_LDB(B1, 1, 1); PG8_STAGE(PG8_SB(1, 0), b3, voffB);
            PG8_BAR; PG8_WAIT_L(0); PG8_MMA(0, 1, At, B1); PG8_BAR;
            PG8_LDA(At, 1, 1); PG8_STAGE(PG8_SA(1, 0), a3, voffA);
            PG8_BAR; PG8_WAIT_L(0); PG8_MMA(1, 0, At, B0); PG8_BAR; PG8_SCHED;
            PG8_STAGE(PG8_SB(1, 1), b3 + hstepB, voffB);
            PG8_WAIT_V(6); PG8_BAR; PG8_MMA(1, 1, At, B1); PG8_BAR;
            }
        }
        if constexpr (ALIGN_EPI) { if (wr == 0) PG8_BAR; }
        E(acc, cur, wr, wc, fr, fq);
        if (!has_next) break;
#pragma unroll
        for (int a = 0; a < 2; ++a)
#pragma unroll
            for (int b = 0; b < 2; ++b)
#pragma unroll
                for (int m = 0; m < 4; ++m)
#pragma unroll
                    for (int n = 0; n < 2; ++n) acc[a][b][m][n] = (f32x4){0.f, 0.f, 0.f, 0.f};
        cur = nxt; cA = nA; cB = nB; ++ui;
        if constexpr (ALIGN_EPI) { if (wr == 1) PG8_BAR; }
    }
    PG8_WAIT_V(0);
    if constexpr (!ALIGN_EPI) { if (wr == 0) PG8_BAR; }
    PG8_BAR;
#undef PG8_SA
#undef PG8_SB
#undef PG8_STAGE
#undef PG8_LDA
#undef PG8_LDB
#undef PG8_MMA
#undef PG8_WAIT_V
#undef PG8_WAIT_L
#undef PG8_BAR
#undef PG8_SCHED
}
}

struct Args {
    const float *x, *c, *w_ada, *b_ada, *norm1_w, *w_in, *w_gate_up, *b_gate, *gla_norm_w, *conv_w, *w_proj_a, *w_proj_b, *w_out, *norm2_w, *w_mlp1, *w_mlp2, *final_norm_w;
    float* out; unsigned char* ws; int ph_lo, ph_hi;
};

#define LDS_WAIT() asm volatile("s_waitcnt lgkmcnt(0)" ::: "memory")

__device__ __forceinline__ void p0_mod(const Args& a, float* mod, int gw, int NGW, int lane) {
    for (int it = gw; it < 24 * 64; it += NGW) {
        const int cb = it % 24, kc = it / 24, col = cb * 256 + lane * 4, k0 = kc * 16;
        f32x4 s0 = {0.f, 0.f, 0.f, 0.f}, s1 = s0, s2 = s0, s3 = s0;
#pragma unroll
        for (int kk = 0; kk < 16; ++kk) {
            const f32x4 w = *(const f32x4*)(a.w_ada + (size_t)(k0 + kk) * NMOD + col);
            const float c0 = a.c[0 * D + k0 + kk], c1 = a.c[1 * D + k0 + kk], c2 = a.c[2 * D + k0 + kk], c3 = a.c[3 * D + k0 + kk];
            s0 += w * (c0 * sigmoidf_(c0)); s1 += w * (c1 * sigmoidf_(c1)); s2 += w * (c2 * sigmoidf_(c2)); s3 += w * (c3 * sigmoidf_(c3));
        }
        if (kc == 0) { const f32x4 bv = *(const f32x4*)(a.b_ada + col); s0 += bv; s1 += bv; s2 += bv; s3 += bv; }
#pragma unroll
        for (int e = 0; e < 4; ++e) { atomicAdd(mod + 0 * NMOD + col + e, s0[e]); atomicAdd(mod + 1 * NMOD + col + e, s1[e]); atomicAdd(mod + 2 * NMOD + col + e, s2[e]); atomicAdd(mod + 3 * NMOD + col + e, s3[e]); }
    }
}
__device__ __forceinline__ void tr_item(const float* W, int ldw, int k0, int sc0, bf16_t* WT, int ldd, int dr0, int dk0, LAS float* scr, int lane) {
#pragma unroll 8
    for (int i = 0; i < 32; ++i) { const int kk = 2 * i + (lane >> 5); scr[kk * 33 + (lane & 31)] = W[(size_t)(k0 + kk) * ldw + sc0 + (lane & 31)]; }
    LDS_WAIT(); asm volatile("" ::: "memory");
    const int c = lane & 7;
#pragma unroll
    for (int j = 0; j < 4; ++j) { const int n = (lane >> 3) + 8 * j; const LAS float* s = scr + (8 * c) * 33 + n;
        u32x4 o; o.x = pk2(s[0 * 33], s[1 * 33]); o.y = pk2(s[2 * 33], s[3 * 33]); o.z = pk2(s[4 * 33], s[5 * 33]); o.w = pk2(s[6 * 33], s[7 * 33]);
        *(u32x4*)(WT + (size_t)(dr0 + n) * ldd + dk0 + k0 + 8 * c) = o; }
    LDS_WAIT(); asm volatile("" ::: "memory");
}
__device__ __forceinline__ void p0_weights(const Args& a, LAS unsigned char* lds, int gw, int NGW, int wave, int lane) {
    LAS float* scr = (LAS float*)(lds + wave * 16384);
    unsigned char* ws = a.ws;
    bf16_t* W1A = (bf16_t*)(ws + WS_W1A); bf16_t* W1B = (bf16_t*)(ws + WS_W1B); bf16_t* WAB = (bf16_t*)(ws + WS_WAB);
    bf16_t* WOUT = (bf16_t*)(ws + WS_WOUT); bf16_t* WM1 = (bf16_t*)(ws + WS_WM1); bf16_t* WM2 = (bf16_t*)(ws + WS_WM2);
    constexpr int I_IN = 16 * 256, I_SQ = 16 * 32, I_M1 = 16 * 128, I_M2 = 64 * 32;
    constexpr int NITEMS = I_IN + 3 * I_SQ + I_M1 + I_M2;
    for (int it = gw; it < NITEMS; it += NGW) {
        int r = it;
        if (r < I_IN) { const int kb = r / 256, cbk = r % 256;
            if (cbk < 96) tr_item(a.w_in, INW, 64 * kb, 32 * cbk, W1A, D, 32 * cbk, 0, scr, lane);
            else { const int e = 32 * (cbk - 96), gi = e >> 10, ch = e & 1023; int dr;
                if (gi == 0) dr = ch; else if (gi == 1) dr = 1024 + 256 * (ch >> 7) + (ch & 127); else if (gi == 2) dr = 1024 + 256 * (ch >> 7) + 128 + (ch & 127); else if (gi == 3) dr = 3072 + ch; else dr = 4096 + ch;
                tr_item(a.w_in, INW, 64 * kb, REST_COL + e, W1B, D, dr, 0, scr, lane); }
            continue; } r -= I_IN;
        if (r < I_SQ) { tr_item(a.w_proj_a, D, 64 * (r / 32), 32 * (r % 32), WAB, 2 * D, 32 * (r % 32), 0, scr, lane); continue; } r -= I_SQ;
        if (r < I_SQ) { tr_item(a.w_proj_b, D, 64 * (r / 32), 32 * (r % 32), WAB, 2 * D, 32 * (r % 32), D, scr, lane); continue; } r -= I_SQ;
        if (r < I_SQ) { tr_item(a.w_out, D, 64 * (r / 32), 32 * (r % 32), WOUT, D, 32 * (r % 32), 0, scr, lane); continue; } r -= I_SQ;
        if (r < I_M1) { tr_item(a.w_mlp1, FF, 64 * (r / 128), 32 * (r % 128), WM1, D, 32 * (r % 128), 0, scr, lane); continue; } r -= I_M1;
        tr_item(a.w_mlp2, D, 64 * (r / 32), 32 * (r % 32), WM2, FF, 32 * (r % 32), 0, scr, lane);
    }
}

template <bool WITH_LR>
__device__ __forceinline__ void norm_mod_rows(const Args& a, LAS unsigned char* lds, const float* X, const float* nw, const float* mod, int shift_off, int scale_off, bf16_t* H, float* LR, int G, int tid, int wave, int lane) {
    LAS float* wl = (LAS float*)lds;
    if (WITH_LR) {
        for (int i = tid; i < 16 * 1024; i += NTHR) { const int k = i >> 4, j = i & 15; wl[j * 1024 + k] = a.w_in[(size_t)k * INW + LR_COL + j]; }
        __syncthreads();
    }
    for (int rb = blockIdx.x; rb < M / 64; rb += G) {
        const int b = rb >> 6;
        f32x4 al[4], sh[4];
#pragma unroll
        for (int j = 0; j < 4; ++j) { const int k = 4 * lane + 256 * j; const f32x4 w = *(const f32x4*)(nw + k), sc = *(const f32x4*)(mod + (size_t)b * NMOD + scale_off + k);
            al[j] = w * (sc + 1.0f); sh[j] = *(const f32x4*)(mod + (size_t)b * NMOD + shift_off + k); }
        for (int r = wave; r < 64; r += NWAVES) {
            const int row = rb * 64 + r;
            const f32x4* xr = (const f32x4*)(X + (size_t)row * D) + lane;
            f32x4 v[4]; float ss = 0.f;
#pragma unroll
            for (int j = 0; j < 4; ++j) { v[j] = xr[64 * j]; ss += (v[j].x * v[j].x + v[j].y * v[j].y) + (v[j].z * v[j].z + v[j].w * v[j].w); }
            const float rstd = 1.0f / sqrtf(wave_sum(ss) * (1.0f / D) + EPS);
#pragma unroll
            for (int j = 0; j < 4; ++j) v[j] = v[j] * rstd * al[j] + sh[j];
            unsigned long long* o8 = (unsigned long long*)(H + (size_t)row * D) + lane;
#pragma unroll
            for (int j = 0; j < 4; ++j) o8[64 * j] = (unsigned long long)pk2(v[j].x, v[j].y) | ((unsigned long long)pk2(v[j].z, v[j].w) << 32);
            if (WITH_LR) {
                float mine = 0.f;
#pragma unroll 1
                for (int jj = 0; jj < 16; ++jj) { float p = 0.f;
#pragma unroll
                    for (int j = 0; j < 4; ++j) { const f32x4 w = *(const LAS f32x4*)(wl + jj * 1024 + 4 * lane + 256 * j); p += (v[j].x * w.x + v[j].y * w.y) + (v[j].z * w.z + v[j].w * w.w); }
                    p = wave_sum(p); if (lane == jj) mine = p; }
                if (lane < 16) LR[(size_t)row * 16 + lane] = mine;
            }
        }
    }
}

__device__ __forceinline__ void gla_prep(const Args& a, LAS unsigned char* lds, bf16_t* R1, bf16_t* KET, float* DEC, const float* LR, int G, int tid) {
    const int d = tid & 127, seg = tid >> 7;
    LAS float* lrS = (LAS float*)lds;
    LAS float* segS = (LAS float*)(lds + 4096);
    for (int cu = blockIdx.x; cu < 1024; cu += G) {
        const int h = cu & 3, bc = cu >> 2, b = bc >> 6, c = bc & 63, row0 = b * SEQ + c * 64;
        if (tid < 256) { const f32x4 v = *(const f32x4*)(LR + (size_t)row0 * 16 + tid * 4); *(LAS f32x4*)(lrS + tid * 4) = v; }
        float wg[16];
#pragma unroll
        for (int r = 0; r < 16; ++r) wg[r] = a.w_gate_up[r * 512 + h * 128 + d];
        const float bgd = a.b_gate[h * 128 + d];
        bf16_t* qp = R1 + (size_t)(row0 + 16 * seg) * 3072 + h * 128 + d; bf16_t* kp = qp + 512;
        unsigned short qv[16], kv[16];
#pragma unroll
        for (int i = 0; i < 16; ++i) { qv[i] = qp[(size_t)i * 3072]; kv[i] = kp[(size_t)i * 3072]; }
        __syncthreads();
        float cum[16]; float run = 0.f;
#pragma unroll
        for (int i = 0; i < 16; ++i) { const int t = 16 * seg + i; float z = bgd;
#pragma unroll
            for (int r4 = 0; r4 < 4; ++r4) { const f32x4 l = *(const LAS f32x4*)(lrS + t * 16 + 4 * r4); z += (l.x * wg[4 * r4] + l.y * wg[4 * r4 + 1]) + (l.z * wg[4 * r4 + 2] + l.w * wg[4 * r4 + 3]); }
            const float ls = fminf(z, 0.f) - __logf(1.0f + __expf(-fabsf(z)));
            run += ls * (1.0f / 16.0f); cum[i] = run; }
        segS[seg * 128 + d] = run;
        __syncthreads();
        float pre = 0.f, tot = 0.f;
#pragma unroll
        for (int s2 = 0; s2 < 4; ++s2) { const float v = segS[s2 * 128 + d]; tot += v; if (s2 < seg) pre += v; }
        unsigned kee[8];
#pragma unroll
        for (int i = 0; i < 16; i += 2) {
            const float b0 = pre + cum[i], b1 = pre + cum[i + 1];
            const float q0 = bf2f(qv[i]) * __expf(b0) * 0.08838834764831845f, q1 = bf2f(qv[i + 1]) * __expf(b1) * 0.08838834764831845f;
            const float kf0 = bf2f(kv[i]), kf1 = bf2f(kv[i + 1]);
            qp[(size_t)i * 3072] = (bf16_t)f2bf(q0); qp[(size_t)(i + 1) * 3072] = (bf16_t)f2bf(q1);
            kp[(size_t)i * 3072] = (bf16_t)f2bf(kf0 * __expf(-b0)); kp[(size_t)(i + 1) * 3072] = (bf16_t)f2bf(kf1 * __expf(-b1));
            kee[i >> 1] = pk2(kf0 * __expf(tot - b0), kf1 * __expf(tot - b1));
        }
        u32x4* kep = (u32x4*)(KET + (size_t)cu * 8192 + d * 64 + 16 * seg);
        kep[0] = (u32x4){kee[0], kee[1], kee[2], kee[3]}; kep[1] = (u32x4){kee[4], kee[5], kee[6], kee[7]};
        if (seg == 0) DEC[(size_t)cu * 128 + d] = __expf(tot);
        __syncthreads();
    }
}

__device__ __forceinline__ void gla_main(LAS unsigned char* lds, const bf16_t* R1, const bf16_t* KET, const float* DEC, bf16_t* O, int G, int tid, int wave, int lane) {
    constexpr int OFF_QD = 0, OFF_KD = 17408, OFF_KE = 34816, OFF_VT = 53248, OFF_P = 55552, OFF_SB = 64768, OFF_DEC = 73472;
    const int fr = lane & 15, fq = lane >> 4;
    for (int unit = blockIdx.x; unit < 256; unit += G) {
        const int bh = unit >> 4, s = unit & 15, b = bh >> 2, h = bh & 3, j0 = s * 16;
        for (int i = tid; i < 2 * 16 * 272 / 4; i += NTHR) ((LAS unsigned*)(lds + OFF_SB))[i] = 0u;
        f32x4 Sacc[2]; Sacc[0] = (f32x4){0.f, 0.f, 0.f, 0.f}; Sacc[1] = Sacc[0];
        u32x4 rq[2], rk[2], re[2], rv = {0u, 0u, 0u, 0u}; float rdec = 0.f;
#define GLA_LOADC(cc) do { const int row0_ = b * SEQ + (cc) * 64; const size_t cu_ = (size_t)((b * 64 + (cc)) * 4 + h); \
        _Pragma("unroll") for (int i_ = 0; i_ < 2; ++i_) { const int p_ = tid + 512 * i_; \
            rq[i_] = *(const u32x4*)(R1 + (size_t)(row0_ + (p_ >> 4)) * 3072 + h * 128 + (p_ & 15) * 8); \
            rk[i_] = *(const u32x4*)(R1 + (size_t)(row0_ + (p_ >> 4)) * 3072 + 512 + h * 128 + (p_ & 15) * 8); \
            re[i_] = *(const u32x4*)(KET + cu_ * 8192 + (p_ >> 3) * 64 + (p_ & 7) * 8); } \
        if (tid < 128) rv = *(const u32x4*)(R1 + (size_t)(row0_ + (tid >> 1)) * 3072 + 1024 + h * 256 + j0 + 8 * (tid & 1)); \
        else if (tid < 256) rdec = DEC[cu_ * 128 + (tid - 128)]; } while (0)
        GLA_LOADC(0);
        for (int c = 0; c < 64; ++c) {
            const int row0 = b * SEQ + c * 64;
#pragma unroll
            for (int i = 0; i < 2; ++i) { const int p = tid + 512 * i;
                *(LAS u32x4*)(lds + OFF_QD + (p >> 4) * 272 + (p & 15) * 16) = rq[i];
                *(LAS u32x4*)(lds + OFF_KD + (p >> 4) * 272 + (p & 15) * 16) = rk[i];
                *(LAS u32x4*)(lds + OFF_KE + (p >> 3) * 144 + (p & 7) * 16) = re[i]; }
            if (tid < 128) { const int t = tid >> 1, hf = tid & 1; LAS unsigned short* vt = (LAS unsigned short*)(lds + OFF_VT);
#pragma unroll
                for (int e = 0; e < 4; ++e) { vt[(8 * hf + 2 * e) * 72 + t] = (unsigned short)(rv[e] & 0xffffu); vt[(8 * hf + 2 * e + 1) * 72 + t] = (unsigned short)(rv[e] >> 16); } }
            else if (tid < 256) ((LAS float*)(lds + OFF_DEC))[tid - 128] = rdec;
            if (c + 1 < 64) GLA_LOADC(c + 1);
            __syncthreads();
            { const int tm = wave >> 1;
#pragma unroll
              for (int q = 0; q < 2; ++q) { const int tn = 2 * (wave & 1) + q; f32x4 sa = {0.f, 0.f, 0.f, 0.f};
                if (tn <= tm) {
#pragma unroll
                    for (int ks = 0; ks < 4; ++ks) { const bf16x8 av = *(const LAS bf16x8*)(lds + OFF_QD + (16 * tm + fr) * 272 + (32 * ks + 8 * fq) * 2);
                        const bf16x8 bv = *(const LAS bf16x8*)(lds + OFF_KD + (16 * tn + fr) * 272 + (32 * ks + 8 * fq) * 2);
                        sa = __builtin_amdgcn_mfma_f32_16x16x32_bf16(av, bv, sa, 0, 0, 0); } }
                LAS unsigned short* pp = (LAS unsigned short*)(lds + OFF_P);
#pragma unroll
                for (int i = 0; i < 4; ++i) { const int t = 16 * tm + 4 * fq + i, sc = 16 * tn + fr; pp[t * 72 + sc] = (unsigned short)f2bf(sc <= t ? sa[i] : 0.f); } } }
            __syncthreads();
            const int cur = c & 1;
            if (wave < 4) { const int tm = wave; f32x4 o = {0.f, 0.f, 0.f, 0.f};
#pragma unroll
                for (int ks = 0; ks < 2; ++ks) { const bf16x8 av = *(const LAS bf16x8*)(lds + OFF_P + (16 * tm + fr) * 144 + (32 * ks + 8 * fq) * 2);
                    const bf16x8 bv = *(const LAS bf16x8*)(lds + OFF_VT + fr * 144 + (32 * ks + 8 * fq) * 2);
                    o = __builtin_amdgcn_mfma_f32_16x16x32_bf16(av, bv, o, 0, 0, 0); }
#pragma unroll
                for (int ks = 0; ks < 4; ++ks) { const bf16x8 av = *(const LAS bf16x8*)(lds + OFF_QD + (16 * tm + fr) * 272 + (32 * ks + 8 * fq) * 2);
                    const bf16x8 bv = *(const LAS bf16x8*)(lds + OFF_SB + cur * (16 * 272) + fr * 272 + (32 * ks + 8 * fq) * 2);
                    o = __builtin_amdgcn_mfma_f32_16x16x32_bf16(av, bv, o, 0, 0, 0); }
#pragma unroll
                for (int i = 0; i < 4; ++i) { const int t = 16 * tm + 4 * fq + i; O[(size_t)(row0 + t) * D + h * 256 + j0 + fr] = (bf16_t)f2bf(o[i]); }
            } else {
#pragma unroll
                for (int q = 0; q < 2; ++q) { const int dt = 2 * (wave - 4) + q; f32x4 sa = Sacc[q];
                    const f32x4 dv = *(const LAS f32x4*)(lds + OFF_DEC + (16 * dt + 4 * fq) * 4); sa = sa * dv;
#pragma unroll
                    for (int ks = 0; ks < 2; ++ks) { const bf16x8 av = *(const LAS bf16x8*)(lds + OFF_KE + (16 * dt + fr) * 144 + (32 * ks + 8 * fq) * 2);
                        const bf16x8 bv = *(const LAS bf16x8*)(lds + OFF_VT + fr * 144 + (32 * ks + 8 * fq) * 2);
                        sa = __builtin_amdgcn_mfma_f32_16x16x32_bf16(av, bv, sa, 0, 0, 0); }
                    Sacc[q] = sa;
                    *(LAS u32x2*)(lds + OFF_SB + (cur ^ 1) * (16 * 272) + fr * 272 + (16 * dt + 4 * fq) * 2) = (u32x2){pk2(sa[0], sa[1]), pk2(sa[2], sa[3])}; }
            }
            __syncthreads();
        }
#undef GLA_LOADC
    }
}

__device__ __forceinline__ void gla_post(const Args& a, const bf16_t* O, const bf16_t* R1, bf16_t* AAB, int gw, int NGW, int lane) {
    const f32x4 gw4 = *(const f32x4*)(a.gla_norm_w + 4 * lane);
    for (int row = gw; row < M; row += NGW) {
#pragma unroll
        for (int h = 0; h < 4; ++h) {
            const u32x2 ov = *(const u32x2*)(O + (size_t)row * D + h * 256 + 4 * lane);
            const u32x2 gv = *(const u32x2*)(R1 + (size_t)row * 3072 + 2048 + h * 256 + 4 * lane);
            const float o0 = bflo(ov.x), o1 = bfhi(ov.x), o2 = bflo(ov.y), o3 = bfhi(ov.y);
            const float rstd = 1.0f / sqrtf(wave_sum((o0 * o0 + o1 * o1) + (o2 * o2 + o3 * o3)) * (1.0f / 256.0f) + EPS);
            const float g0 = bflo(gv.x), g1 = bfhi(gv.x), g2 = bflo(gv.y), g3 = bfhi(gv.y);
            u32x2 w; w.x = pk2(o0 * rstd * gw4.x * (g0 * sigmoidf_(g0)), o1 * rstd * gw4.y * (g1 * sigmoidf_(g1)));
            w.y = pk2(o2 * rstd * gw4.z * (g2 * sigmoidf_(g2)), o3 * rstd * gw4.w * (g3 * sigmoidf_(g3)));
            *(u32x2*)(AAB + (size_t)row * 2048 + h * 256 + 4 * lane) = w;
        }
    }
}

__device__ __forceinline__ void conv_phase(const Args& a, const bf16_t* R2, bf16_t* AAB, int gw, int NGW, int lane) {
    const int ch = 16 * lane;
    float w0[16], w1[16], w2[16];
#pragma unroll
    for (int q = 0; q < 4; ++q) { const f32x4 x0 = *(const f32x4*)(a.conv_w + 0 * D + ch + 4 * q), x1 = *(const f32x4*)(a.conv_w + 1 * D + ch + 4 * q), x2 = *(const f32x4*)(a.conv_w + 2 * D + ch + 4 * q);
#pragma unroll
        for (int e = 0; e < 4; ++e) { w0[4 * q + e] = x0[e]; w1[4 * q + e] = x1[e]; w2[4 * q + e] = x2[e]; } }
    for (int rr = gw; rr < M / 8; rr += NGW) {
        const int t0 = rr * 8;
        u32x4 um2[2], um1[2];
        if ((t0 & (SEQ - 1)) == 0) { um2[0] = um2[1] = um1[0] = um1[1] = (u32x4){0u, 0u, 0u, 0u}; }
        else { const bf16_t* p2 = R2 + (size_t)(t0 - 2) * 4096 + 1024 + ch; const bf16_t* p1 = p2 + 4096;
            um2[0] = *(const u32x4*)p2; um2[1] = *(const u32x4*)(p2 + 8); um1[0] = *(const u32x4*)p1; um1[1] = *(const u32x4*)(p1 + 8); }
#pragma unroll
        for (int i = 0; i < 8; ++i) {
            const bf16_t* rp = R2 + (size_t)(t0 + i) * 4096;
            u32x4 u0[2], cb[2]; u0[0] = *(const u32x4*)(rp + 1024 + ch); u0[1] = *(const u32x4*)(rp + 1024 + ch + 8); cb[0] = *(const u32x4*)(rp + ch); cb[1] = *(const u32x4*)(rp + ch + 8);
            u32x4 ow[2];
#pragma unroll
            for (int hv = 0; hv < 2; ++hv)
#pragma unroll
                for (int q = 0; q < 4; ++q) { const int e = 8 * hv + 2 * q;
                    const float y0 = w0[e] * bflo(um2[hv][q]) + w1[e] * bflo(um1[hv][q]) + w2[e] * bflo(u0[hv][q]);
                    const float y1 = w0[e + 1] * bfhi(um2[hv][q]) + w1[e + 1] * bfhi(um1[hv][q]) + w2[e + 1] * bfhi(u0[hv][q]);
                    ow[hv][q] = pk2(bflo(cb[hv][q]) * y0, bfhi(cb[hv][q]) * y1); }
            bf16_t* op = AAB + (size_t)(t0 + i) * 2048 + 1024 + ch;
            *(u32x4*)op = ow[0]; *(u32x4*)(op + 8) = ow[1];
            um2[0] = um1[0]; um2[1] = um1[1]; um1[0] = u0[0]; um1[1] = u0[1];
        }
    }
}

__device__ __forceinline__ void final_norm(const Args& a, float* X, int gw, int NGW, int lane) {
    f32x4 w[4];
#pragma unroll
    for (int j = 0; j < 4; ++j) w[j] = *(const f32x4*)(a.final_norm_w + 4 * lane + 256 * j);
    for (int row = gw; row < M; row += NGW) {
        f32x4* xr = (f32x4*)(X + (size_t)row * D) + lane;
        f32x4 v[4]; float ss = 0.f;
#pragma unroll
        for (int j = 0; j < 4; ++j) { v[j] = xr[64 * j]; ss += (v[j].x * v[j].x + v[j].y * v[j].y) + (v[j].z * v[j].z + v[j].w * v[j].w); }
        const float rstd = 1.0f / sqrtf(wave_sum(ss) * (1.0f / D) + EPS);
#pragma unroll
        for (int j = 0; j < 4; ++j) xr[64 * j] = v[j] * rstd * w[j];
    }
}

__global__ void __launch_bounds__(NTHR, 2) fwd_megakernel(Args a) {
    extern __shared__ __attribute__((aligned(16))) unsigned char lds_raw[];
    LAS unsigned char* lds = (LAS unsigned char*)lds_raw;
    cg::grid_group grid = cg::this_grid();
    const int tid = threadIdx.x, lane = tid & 63, wave = __builtin_amdgcn_readfirstlane(tid >> 6);
    const int G = gridDim.x, gw = blockIdx.x * NWAVES + wave, NGW = G * NWAVES;
    unsigned char* ws = a.ws;
    float* mod = (float*)(ws + WS_MOD);
    bf16_t* W1A = (bf16_t*)(ws + WS_W1A); bf16_t* W1B = (bf16_t*)(ws + WS_W1B); bf16_t* WAB = (bf16_t*)(ws + WS_WAB);
    bf16_t* WOUT = (bf16_t*)(ws + WS_WOUT); bf16_t* WM1 = (bf16_t*)(ws + WS_WM1); bf16_t* WM2 = (bf16_t*)(ws + WS_WM2);
    float* LR = (float*)(ws + WS_LR); float* DEC = (float*)(ws + WS_DEC);
    bf16_t* R = (bf16_t*)(ws + WS_R); bf16_t* KET = (bf16_t*)(ws + WS_KET); bf16_t* AAB = (bf16_t*)(ws + WS_AAB);
    bf16_t* Hb = (bf16_t*)a.out; bf16_t* Ob = (bf16_t*)((unsigned char*)a.out + 32 * MiB);
    const int lo = a.ph_lo, hi = a.ph_hi;
#ifndef PHASE_MASK
#define PHASE_MASK 0xffff
#endif
#define IN(k) (((PHASE_MASK >> (k)) & 1) && lo <= (k) && (k) < hi)
#define SEAM(k) do { if (IN(k) && IN((k) + 1)) grid.sync(); } while (0)

    if (IN(0)) { p0_mod(a, mod, gw, NGW, lane); p0_weights(a, lds, gw, NGW, wave, lane); }
    SEAM(0);
    if (IN(1)) { norm_mod_rows<true>(a, lds, a.x, a.norm1_w, mod, 0, D, Hb, LR, G, tid, wave, lane); __syncthreads(); }
    SEAM(1);
    if (IN(2)) { pg8::Gemm g{Hb, W1A, M, 3072, D, D}; pg8::StaticOrder S; S.init(M, 3072, G, (int)blockIdx.x);
        pg8::EpiBf16<0> E{R, 3072}; pg8::gemm_phase<pg8::EpiBf16<0>, pg8::StaticOrder, true, true>(lds, g, S, E); }
    SEAM(2);
    if (IN(3)) gla_prep(a, lds, R, KET, DEC, LR, G, tid);
    SEAM(3);
    if (IN(4)) gla_main(lds, R, KET, DEC, Ob, G, tid, wave, lane);
    SEAM(4);
    if (IN(5)) gla_post(a, Ob, R, AAB, gw, NGW, lane);
    SEAM(5);
    if (IN(6)) { pg8::Gemm g{Hb, W1B, M, 5120, D, D}; pg8::StaticOrder S; S.init(M, 5120, G, (int)blockIdx.x);
        pg8::EpiG1b E{R, 4096}; pg8::gemm_phase<pg8::EpiG1b, pg8::StaticOrder, true, true>(lds, g, S, E); }
    SEAM(6);
    if (IN(7)) conv_phase(a, R, AAB, gw, NGW, lane);
    SEAM(7);
    if (IN(8)) { pg8::Gemm g{AAB, WAB, M, D, 2 * D, 2 * D}; pg8::StaticOrder S; S.init(M, D, G, (int)blockIdx.x);
        pg8::EpiZ E{R + 2048, R + 3072, 4096, R + 1024, 4096}; pg8::gemm_phase<pg8::EpiZ, pg8::StaticOrder, false, true>(lds, g, S, E); }
    SEAM(8);
    if (IN(9)) { pg8::Gemm g{R + 1024, WOUT, M, D, D, 4096}; pg8::StaticOrder S; S.init(M, D, G, (int)blockIdx.x);
        pg8::EpiRes E{a.x, a.out, D, mod + 2 * D}; pg8::gemm_phase<pg8::EpiRes, pg8::StaticOrder, false, true>(lds, g, S, E); }
    SEAM(9);
    if (IN(10)) norm_mod_rows<false>(a, lds, a.out, a.norm2_w, mod, 3 * D, 4 * D, AAB, nullptr, G, tid, wave, lane);
    SEAM(10);
    if (IN(11)) { pg8::Gemm g{AAB, WM1, M, FF, D, D}; pg8::StaticOrder S; S.init(M, FF, G, (int)blockIdx.x);
        pg8::EpiBf16<1> E{R, FF}; pg8::gemm_phase<pg8::EpiBf16<1>, pg8::StaticOrder, true, true>(lds, g, S, E); }
    SEAM(11);
    if (IN(12)) { pg8::Gemm g{R, WM2, M, D, FF, FF}; pg8::StaticOrder S; S.init(M, D, G, (int)blockIdx.x);
        pg8::EpiRes E{a.out, a.out, D, mod + 5 * D}; pg8::gemm_phase<pg8::EpiRes, pg8::StaticOrder, false, true>(lds, g, S, E); }
    SEAM(12);
    if (IN(13)) final_norm(a, a.out, gw, NGW, lane);
#undef IN
#undef SEAM
}

extern "C" void kernel_launch(void* const* d_in, const int* in_sizes, int n_in, void* d_out, int out_size, void* d_ws, size_t ws_size, hipStream_t stream) {
    static int grid = 0;
    if (grid == 0) {
        if (n_in != 17 || in_sizes[0] != M * D || out_size != M * D || ws_size < WS_END) { fprintf(stderr, "kernel_launch: unexpected shapes (n_in %d, in0 %d, out %d, ws %zu)\n", n_in, n_in > 0 ? in_sizes[0] : -1, out_size, ws_size); grid = -1; return; }
        int dev = 0, cus = 0, per_cu = 0;
        if (hipGetDevice(&dev) != hipSuccess || hipDeviceGetAttribute(&cus, hipDeviceAttributeMultiprocessorCount, dev) != hipSuccess) { grid = -1; return; }
        if (hipFuncSetAttribute((const void*)fwd_megakernel, hipFuncAttributeMaxDynamicSharedMemorySize, LDS_BYTES) != hipSuccess) { fprintf(stderr, "kernel_launch: hipFuncSetAttribute failed\n"); grid = -1; return; }
        if (hipOccupancyMaxActiveBlocksPerMultiprocessor(&per_cu, (const void*)fwd_megakernel, NTHR, LDS_BYTES) != hipSuccess || per_cu < 1) { fprintf(stderr, "kernel_launch: occupancy query says %d\n", per_cu); per_cu = 1; }
        (void)hipGetLastError();
        grid = cus;
    }
    if (grid < 0) return;
    if (hipMemsetAsync((char*)d_ws + WS_CTL, 0, CTL_ZERO_BYTES, stream) != hipSuccess) { fprintf(stderr, "kernel_launch: memset failed\n"); return; }
    Args a{};
    const float** pp = (const float**)&a;
    for (int i = 0; i < 17; ++i) pp[i] = (const float*)d_in[i];
    a.out = (float*)d_out; a.ws = (unsigned char*)d_ws; a.ph_lo = 0; a.ph_hi = 14;
    void* args[] = {&a};
    hipError_t e = hipLaunchCooperativeKernel((const void*)fwd_megakernel, dim3(grid), dim3(NTHR), args, LDS_BYTES, stream);
    if (e != hipSuccess) fprintf(stderr, "kernel_launch: cooperative launch failed: %s (grid %d)\n", hipGetErrorString(e), grid);
}
```

```cpp
#include <hip/hip_runtime.h>
#include <hip/hip_cooperative_groups.h>
#include <cstdio>
#include <cstdint>
namespace cg = cooperative_groups;

#define LAS __attribute__((address_space(3)))
typedef unsigned short bf16_t;
typedef short bf16x8 __attribute__((ext_vector_type(8)));
typedef float f32x4 __attribute__((ext_vector_type(4)));
typedef float f32x2 __attribute__((ext_vector_type(2)));
typedef unsigned u32x4 __attribute__((ext_vector_type(4)));
typedef unsigned u32x2 __attribute__((ext_vector_type(2)));

constexpr int BATCH = 4, SEQ = 4096, D = 1024, M = BATCH * SEQ, FF = 4096, INW = 8208, NMOD = 6 * D;
constexpr int LR_COL = 3072;
constexpr int REST_COL = 3088;
constexpr float EPS = 1e-6f;
constexpr int NWAVES = 8, NTHR = 512;

constexpr size_t MiB = 1u << 20;
constexpr size_t WS_CTL = 0, CTL_ZERO_BYTES = 1 * MiB;
constexpr size_t WS_BAR = 16 * 1024;
constexpr size_t WS_MOD = 64 * 1024;
constexpr size_t WS_W1A = 2 * MiB;
constexpr size_t WS_W1B = 8 * MiB;
constexpr size_t WS_WAB = 18 * MiB;
constexpr size_t WS_WOUT = 22 * MiB;
constexpr size_t WS_WM1 = 24 * MiB;
constexpr size_t WS_WM2 = 32 * MiB;
constexpr size_t WS_LR = 40 * MiB;
constexpr size_t WS_DEC = 41 * MiB;
constexpr size_t WS_R = 48 * MiB;
constexpr size_t WS_KET = WS_R + 96 * MiB;
constexpr size_t WS_AAB = 176 * MiB;
constexpr size_t WS_END = 240 * MiB;

constexpr int LDS_BYTES = 147456;

__device__ __forceinline__ unsigned f2bf(float f) { unsigned u = __builtin_bit_cast(unsigned, f); return (u + 0x7fffu + ((u >> 16) & 1u)) >> 16; }
__device__ __forceinline__ unsigned pk2(float lo, float hi) { return f2bf(lo) | (f2bf(hi) << 16); }
__device__ __forceinline__ float bf2f(unsigned short v) { return __builtin_bit_cast(float, (unsigned)v << 16); }
__device__ __forceinline__ float bflo(unsigned w) { return __builtin_bit_cast(float, w << 16); }
__device__ __forceinline__ float bfhi(unsigned w) { return __builtin_bit_cast(float, w & 0xffff0000u); }
__device__ __forceinline__ float wave_sum(float v) {
#pragma unroll
    for (int o = 1; o < 64; o <<= 1) v += __shfl_xor(v, o);
    return v;
}
__device__ __forceinline__ float sigmoidf_(float v) { return 1.0f / (1.0f + __expf(-v)); }

namespace pg8 {
constexpr int BM = 256, BK = 64, HALF = 128, HTB = HALF * BK * 2, STAGE_BYTES = 8 * HTB, NXCD = 8, WGM = 8;
__host__ __device__ __forceinline__ int lds_byte(int r, int c) { const int st = (r >> 4) * 2 + (c >> 5), rr = r & 15, cc = c & 31, ob = rr * 64 + cc * 2; return st * 1024 + (ob ^ (((ob >> 9) & 1) << 5)); }
__host__ __device__ __forceinline__ void stage_rc(int b, int& R, int& C) { const int st = b / 1024, sb = b % 1024, swz = sb ^ (((sb >> 9) & 1) << 5); R = (st >> 1) * 16 + swz / 64; C = (st & 1) * 32 + (swz % 64) / 2; }
__host__ __device__ __forceinline__ int perm32(int rho) { const int n = rho >> 4, i = rho & 15; return 8 * (i >> 2) + 4 * n + (i & 3); }

struct Unit { int pm, pn; };
struct Gemm { const bf16_t* A; const bf16_t* Bt; int M, N, K, lda; };

struct StaticOrder {
    int nM, nN, nwg, G, c;
    __host__ __device__ void init(int M_, int N_, int G_, int c_) { nM = M_ / BM; nN = N_ / BM; nwg = nM * nN; G = G_; c = c_; }
    __host__ __device__ bool next(int i, Unit& u) const {
        const long L = (long)i * G + c; if (L >= nwg) return false;
        int wgid = (int)L; { const int q = nwg / NXCD, r = nwg % NXCD, xcd = wgid % NXCD, off = wgid / NXCD; wgid = (xcd < r ? xcd * (q + 1) : r * (q + 1) + (xcd - r) * q) + off; }
        const int nig = WGM * nN, gid = wgid / nig, fm = gid * WGM, gsz = (nM - fm) < WGM ? (nM - fm) : WGM;
        u.pm = fm + ((wgid % nig) % gsz); u.pn = (wgid % nig) / gsz; return true;
    }
};

__device__ __forceinline__ unsigned cvt_pk_bf16(float lo, float hi) { unsigned r; asm volatile("v_cvt_pk_bf16_f32 %0, %1, %2" : "=v"(r) : "v"(lo), "v"(hi)); return r; }

template <int ACT  > struct EpiBf16 {
    static constexpr bool PERM = true, HOOK = false;
    bf16_t* O; int ldc;
    __device__ __forceinline__ void hook(f32x4 (&)[2][2][4][2], const Unit&, int, int, int, int) const {}
    __device__ __forceinline__ void operator()(const f32x4 (&acc)[2][2][4][2], const Unit& u, int wr, int wc, int fr, int fq) const {
        int row0 = u.pm * BM + wr * 64 + fr; asm volatile("" : "+v"(row0)); const int col0 = u.pn * BM + wc * 32 + 8 * fq;
#pragma unroll
        for (int ai = 0; ai < 2; ++ai)
#pragma unroll
            for (int m = 0; m < 4; ++m) { bf16_t* rowp = O + (size_t)(row0 + ai * HALF + m * 16) * ldc + col0;
#pragma unroll
                for (int bj = 0; bj < 2; ++bj) { f32x4 v0 = acc[ai][bj][m][0], v1 = acc[ai][bj][m][1];
                    if (ACT == 1) {
#pragma unroll
                        for (int e = 0; e < 4; ++e) { float a0 = fmaxf(v0[e], 0.f), a1 = fmaxf(v1[e], 0.f); v0[e] = a0 * a0; v1[e] = a1 * a1; } }
                    u32x4 w; w.x = cvt_pk_bf16(v0[0], v0[1]); w.y = cvt_pk_bf16(v0[2], v0[3]); w.z = cvt_pk_bf16(v1[0], v1[1]); w.w = cvt_pk_bf16(v1[2], v1[3]);
                    *(u32x4*)(rowp + bj * HALF) = w; } }
    }
};
struct EpiG1b {
    static constexpr bool PERM = true, HOOK = false;
    bf16_t* O; int ldc;
    __device__ __forceinline__ void hook(f32x4 (&)[2][2][4][2], const Unit&, int, int, int, int) const {}
    __device__ __forceinline__ void operator()(const f32x4 (&acc)[2][2][4][2], const Unit& u, int wr, int wc, int fr, int fq) const {
        int row0 = u.pm * BM + wr * 64 + fr; asm volatile("" : "+v"(row0));
        if (u.pn >= 4 && u.pn < 12) {
            const int col0 = 1024 + (u.pn - 4) * 128 + wc * 32 + 8 * fq;
#pragma unroll
            for (int ai = 0; ai < 2; ++ai)
#pragma unroll
                for (int m = 0; m < 4; ++m) { bf16_t* rowp = O + (size_t)(row0 + ai * HALF + m * 16) * ldc + col0;
                    const f32x4 v0 = acc[ai][0][m][0] * acc[ai][1][m][0], v1 = acc[ai][0][m][1] * acc[ai][1][m][1];
                    u32x4 w; w.x = cvt_pk_bf16(v0[0], v0[1]); w.y = cvt_pk_bf16(v0[2], v0[3]); w.z = cvt_pk_bf16(v1[0], v1[1]); w.w = cvt_pk_bf16(v1[2], v1[3]);
                    *(u32x4*)rowp = w; }
        } else {
            const int colt = (u.pn < 4) ? u.pn * 256 : 2048 + (u.pn - 12) * 256; const int col0 = colt + wc * 32 + 8 * fq;
#pragma unroll
            for (int ai = 0; ai < 2; ++ai)
#pragma unroll
                for (int m = 0; m < 4; ++m) { bf16_t* rowp = O + (size_t)(row0 + ai * HALF + m * 16) * ldc + col0;
#pragma unroll
                    for (int bj = 0; bj < 2; ++bj) { const f32x4 v0 = acc[ai][bj][m][0], v1 = acc[ai][bj][m][1];
                        u32x4 w; w.x = cvt_pk_bf16(v0[0], v0[1]); w.y = cvt_pk_bf16(v0[2], v0[3]); w.z = cvt_pk_bf16(v1[0], v1[1]); w.w = cvt_pk_bf16(v1[2], v1[3]);
                        *(u32x4*)(rowp + bj * HALF) = w; } }
        }
    }
};
struct EpiZ {
    static constexpr bool PERM = true, HOOK = true;
    const bf16_t* GA; const bf16_t* GB; int ldg; bf16_t* Z; int ldz;
    __device__ __forceinline__ void hook(f32x4 (&acc)[2][2][4][2], const Unit& u, int wr, int wc, int fr, int fq) const {
        int row0 = u.pm * BM + wr * 64 + fr; asm volatile("" : "+v"(row0)); const int col0 = u.pn * BM + wc * 32 + 8 * fq;
#pragma unroll
        for (int ai = 0; ai < 2; ++ai)
#pragma unroll
            for (int m = 0; m < 4; ++m) { const size_t ro = (size_t)(row0 + ai * HALF + m * 16) * ldg + col0;
#pragma unroll
                for (int bj = 0; bj < 2; ++bj) { const u32x4 a = *(const u32x4*)(GA + ro + bj * HALF), b = *(const u32x4*)(GB + ro + bj * HALF);
#pragma unroll
                    for (int q = 0; q < 4; ++q) { const float ga0 = bflo(a[q]), ga1 = bfhi(a[q]), gb0 = bflo(b[q]), gb1 = bfhi(b[q]);
                        const float r0 = (1.0f + __expf(-gb0)) / (1.0f + __expf(-ga0)), r1 = (1.0f + __expf(-gb1)) / (1.0f + __expf(-ga1));
                        acc[ai][bj][m][q >> 1][(q & 1) * 2] *= r0; acc[ai][bj][m][q >> 1][(q & 1) * 2 + 1] *= r1; } }
                asm volatile("" ::: "memory"); }
    }
    __device__ __forceinline__ void operator()(const f32x4 (&acc)[2][2][4][2], const Unit& u, int wr, int wc, int fr, int fq) const {
        int row0 = u.pm * BM + wr * 64 + fr; asm volatile("" : "+v"(row0)); const int col0 = u.pn * BM + wc * 32 + 8 * fq;
#pragma unroll
        for (int ai = 0; ai < 2; ++ai)
#pragma unroll
            for (int m = 0; m < 4; ++m) { const size_t ro = (size_t)(row0 + ai * HALF + m * 16) * ldg + col0; bf16_t* zp = Z + (size_t)(row0 + ai * HALF + m * 16) * ldz + col0;
#pragma unroll
                for (int bj = 0; bj < 2; ++bj) { const u32x4 b = *(const u32x4*)(GB + ro + bj * HALF); u32x4 w;
#pragma unroll
                    for (int q = 0; q < 4; ++q) { const float s0 = sigmoidf_(bflo(b[q])), s1 = sigmoidf_(bfhi(b[q]));
                        w[q] = cvt_pk_bf16(acc[ai][bj][m][q >> 1][(q & 1) * 2] * s0, acc[ai][bj][m][q >> 1][(q & 1) * 2 + 1] * s1); }
                    *(u32x4*)(zp + bj * HALF) = w; }
                asm volatile("" ::: "memory"); }
    }
};
struct EpiRes {
    static constexpr bool PERM = false, HOOK = false;
    const float* base; float* out; int ldc; const float* gate;
    __device__ __forceinline__ void hook(f32x4 (&)[2][2][4][2], const Unit&, int, int, int, int) const {}
    __device__ __forceinline__ void operator()(const f32x4 (&acc)[2][2][4][2], const Unit& u, int wr, int wc, int fr, int fq) const {
        int row0 = u.pm * BM + wr * 64 + fr; asm volatile("" : "+v"(row0)); const int col0 = u.pn * BM + wc * 32 + 4 * fq; const int b = u.pm >> 4;
        f32x4 gv[2][2];
#pragma unroll
        for (int bj = 0; bj < 2; ++bj)
#pragma unroll
            for (int n = 0; n < 2; ++n) gv[bj][n] = *(const f32x4*)(gate + (size_t)b * NMOD + col0 + bj * HALF + n * 16);
#pragma unroll
        for (int ai = 0; ai < 2; ++ai)
#pragma unroll
            for (int m = 0; m < 4; ++m) { const size_t off = (size_t)(row0 + ai * HALF + m * 16) * ldc + col0;
#pragma unroll
                for (int bj = 0; bj < 2; ++bj)
#pragma unroll
                    for (int n = 0; n < 2; ++n) { const f32x4 bs = *(const f32x4*)(base + off + bj * HALF + n * 16);
                        *(f32x4*)(out + off + bj * HALF + n * 16) = bs + gv[bj][n] * acc[ai][bj][m][n]; } }
    }
};

template <class Epi, class Sched, bool ALIGN_EPI = false, bool SP2 = false>
__device__ __forceinline__ void gemm_phase(LAS unsigned char* lds, const Gemm g, const Sched& S, const Epi& E) {
    const int tid = threadIdx.x, wid = __builtin_amdgcn_readfirstlane(tid >> 6), lane = tid & 63, wr = wid >> 2, wc = wid & 3, fr = lane & 15, fq = lane >> 4;
    const int K = g.K, nt = K / BK, lda = g.lda;
    unsigned voffA[2], voffB[2];
#pragma unroll
    for (int i = 0; i < 2; ++i) { int R, C; stage_rc(tid * 16 + i * 8192, R, C); const int Rb = Epi::PERM ? ((R & ~31) + perm32(R & 31)) : R;
        voffA[i] = (unsigned)(R * lda + C) * 2u; voffB[i] = (unsigned)(Rb * K + C) * 2u; }
    const size_t kstep = (size_t)(BK * 2);
    const size_t hstepA = (size_t)HALF * lda * 2, hstepB = (size_t)HALF * K * 2;
    const size_t tstepA = 2 * hstepA, tstepB = 2 * hstepB;
    const unsigned ldsw = (unsigned)wid * 1024u;
    const int aoff = lds_byte(wr * 64 + fr, fq * 8), boff = lds_byte(wc * 32 + fr, fq * 8);
#define PG8_SA(b, h) (((b) * 2 + (h)) * HTB)
#define PG8_SB(b, h) ((4 + (b) * 2 + (h)) * HTB)
#define PG8_STAGE(bufoff, gbase, voff) do { _Pragma("unroll") for (int _i = 0; _i < 2; ++_i) \
        __builtin_amdgcn_global_load_lds((const unsigned*)((const char*)(gbase) + (voff)[_i]), (LAS unsigned*)(lds + (bufoff) + ldsw + _i * 8192), 16, 0, 0); } while (0)
#define PG8_LDA(dst, b, h) do { _Pragma("unroll") for (int m = 0; m < 4; ++m) _Pragma("unroll") for (int k = 0; k < 2; ++k) dst[m][k] = *(const LAS bf16x8*)(lds + PG8_SA(b, h) + aoff + m * 2048 + k * 1024); } while (0)
#define PG8_LDB(dst, b, h) do { _Pragma("unroll") for (int n = 0; n < 2; ++n) _Pragma("unroll") for (int k = 0; k < 2; ++k) dst[n][k] = *(const LAS bf16x8*)(lds + PG8_SB(b, h) + boff + n * 2048 + k * 1024); } while (0)
#define PG8_MMA(ai, bj, At, Bt) do { __builtin_amdgcn_s_setprio(1); _Pragma("unroll") for (int m = 0; m < 4; ++m) _Pragma("unroll") for (int n = 0; n < 2; ++n) _Pragma("unroll") for (int k = 0; k < 2; ++k) \
        acc[ai][bj][m][n] = __builtin_amdgcn_mfma_f32_16x16x32_bf16(Bt[n][k], At[m][k], acc[ai][bj][m][n], 0, 0, 0); __builtin_amdgcn_s_setprio(0); } while (0)
#define PG8_WAIT_V(n) asm volatile("s_waitcnt vmcnt(" #n ")" ::: "memory")
#define PG8_WAIT_L(n) asm volatile("s_waitcnt lgkmcnt(" #n ")" ::: "memory")
#define PG8_BAR __builtin_amdgcn_s_barrier()
#define PG8_SCHED __builtin_amdgcn_sched_barrier(0)
    Unit cur, nxt; int ui = 0;
    if (!S.next(0, cur)) return;
    f32x4 acc[2][2][4][2];
#pragma unroll
    for (int a = 0; a < 2; ++a)
#pragma unroll
        for (int b = 0; b < 2; ++b)
#pragma unroll
            for (int m = 0; m < 4; ++m)
#pragma unroll
                for (int n = 0; n < 2; ++n) acc[a][b][m][n] = (f32x4){0.f, 0.f, 0.f, 0.f};
    bf16x8 At[4][2], B0[2][2], B1[2][2];
    const char* cA = (const char*)g.A + (size_t)cur.pm * tstepA; const char* cB = (const char*)g.Bt + (size_t)cur.pn * tstepB;
    if constexpr (SP2) {
        PG8_STAGE(PG8_SB(0, 0), cB, voffB); PG8_STAGE(PG8_SB(0, 1), cB + hstepB, voffB); PG8_STAGE(PG8_SA(0, 0), cA, voffA); PG8_STAGE(PG8_SA(0, 1), cA + hstepA, voffA);
        if (wr == 1) PG8_BAR;
        PG8_WAIT_V(2); PG8_BAR;
        PG8_STAGE(PG8_SB(1, 0), cB + kstep, voffB); PG8_STAGE(PG8_SA(1, 0), cA + kstep, voffA); PG8_STAGE(PG8_SB(1, 1), cB + hstepB + kstep, voffB);
        PG8_WAIT_V(6); PG8_BAR;
    } else {
        PG8_STAGE(PG8_SB(0, 0), cB, voffB); PG8_STAGE(PG8_SA(0, 0), cA, voffA); PG8_STAGE(PG8_SB(0, 1), cB + hstepB, voffB); PG8_STAGE(PG8_SA(0, 1), cA + hstepA, voffA);
        if (wr == 1) PG8_BAR;
        PG8_WAIT_V(4); PG8_BAR;
        PG8_STAGE(PG8_SB(1, 0), cB + kstep, voffB); PG8_STAGE(PG8_SA(1, 0), cA + kstep, voffA); PG8_STAGE(PG8_SB(1, 1), cB + hstepB + kstep, voffB);
        PG8_WAIT_V(6); PG8_BAR;
    }
    for (;;) {
        const bool has_next = S.next(ui + 1, nxt);
        const char* nA = has_next ? (const char*)g.A + (size_t)nxt.pm * tstepA : cA; const char* nB = has_next ? (const char*)g.Bt + (size_t)nxt.pn * tstepB : cB;
        for (int t = 0; t < nt; t += 2) {
            const bool last = (t == nt - 2);
            const char* a1 = cA + (size_t)(t + 1) * kstep;
            const char* a2 = last ? nA : cA + (size_t)(t + 2) * kstep; const char* b2 = last ? nB : cB + (size_t)(t + 2) * kstep;
            const char* a3 = a2 + kstep; const char* b3 = b2 + kstep;
            if constexpr (Epi::HOOK) { if (t == (nt >> 1)) { E.hook(acc, cur, wr, wc, fr, fq); asm volatile("" ::: "memory"); } }
            if constexpr (SP2) {
            PG8_LDB(B0, 0, 0); PG8_LDB(B1, 0, 1); PG8_SCHED; PG8_LDA(At, 0, 0); PG8_STAGE(PG8_SA(1, 1), a1 + hstepA, voffA);
            PG8_WAIT_V(8); PG8_WAIT_L(0); PG8_BAR; PG8_MMA(0, 0, At, B0); PG8_MMA(0, 1, At, B1); PG8_BAR; PG8_SCHED;
            PG8_LDA(At, 0, 1); PG8_STAGE(PG8_SB(0, 0), b2, voffB); PG8_STAGE(PG8_SB(0, 1), b2 + hstepB, voffB); PG8_STAGE(PG8_SA(0, 0), a2, voffA);
            PG8_WAIT_V(8); PG8_WAIT_L(0); PG8_BAR; PG8_MMA(1, 0, At, B0); PG8_MMA(1, 1, At, B1); PG8_BAR; PG8_SCHED;
            PG8_LDB(B0, 1, 0); PG8_LDB(B1, 1, 1); PG8_SCHED; PG8_LDA(At, 1, 0); PG8_STAGE(PG8_SA(0, 1), a2 + hstepA, voffA);
            PG8_WAIT_V(8); PG8_WAIT_L(0); PG8_BAR; PG8_MMA(0, 0, At, B0); PG8_MMA(0, 1, At, B1); PG8_BAR; PG8_SCHED;
            PG8_LDA(At, 1, 1); PG8_STAGE(PG8_SB(1, 0), b3, voffB); PG8_STAGE(PG8_SB(1, 1), b3 + hstepB, voffB); PG8_STAGE(PG8_SA(1, 0), a3, voffA);
            PG8_WAIT_V(8); PG8_WAIT_L(0); PG8_BAR; PG8_MMA(1, 0, At, B0); PG8_MMA(1, 1, At, B1); PG8_BAR; PG8_SCHED;
            } else {
            PG8_LDB(B0, 0, 0); PG8_SCHED; PG8_LDA(At, 0, 0); PG8_STAGE(PG8_SA(1, 1), a1 + hstepA, voffA);
            PG8_WAIT_L(8); PG8_BAR; PG8_WAIT_L(0); PG8_MMA(0, 0, At, B0); PG8_BAR; PG8_SCHED;
            PG8_LDB(B1, 0, 1); PG8_STAGE(PG8_SB(0, 0), b2, voffB);
            PG8_BAR; PG8_WAIT_L(0); PG8_MMA(0, 1, At, B1); PG8_BAR;
            PG8_LDA(At, 0, 1); PG8_STAGE(PG8_SA(0, 0), a2, voffA);
            PG8_BAR; PG8_WAIT_L(0); PG8_MMA(1, 0, At, B0); PG8_BAR; PG8_SCHED;
            PG8_STAGE(PG8_SB(0, 1), b2 + hstepB, voffB);
            PG8_WAIT_V(6); PG8_BAR; PG8_MMA(1, 1, At, B1); PG8_BAR;
            PG8_LDB(B0, 1, 0); PG8_SCHED; PG8_LDA(At, 1, 0); PG8_STAGE(PG8_SA(0, 1), a2 + hstepA, voffA);
            PG8_WAIT_L(8); PG8_BAR; PG8_WAIT_L(0); PG8_MMA(0, 0, At, B0); PG8_BAR; PG8_SCHED;
            PG8_LDB(B1, 1, 1); PG8_STAGE(PG8_SB(1, 0), b3, voffB);
            PG8_BAR; PG8_WAIT_L(0); PG8_MMA(0, 1, At, B1); PG8_BAR;
            PG8_LDA(At, 1, 1); PG8_STAGE(PG8_SA(1, 0), a3, voffA);
            PG8_BAR; PG8_WAIT_L(0); PG8_MMA(1, 0, At, B0); PG8_BAR; PG8_SCHED;
            PG8_STAGE(PG8_SB(1, 1), b3 + hstepB, voffB);
            PG8_WAIT_V(6); PG8_BAR; PG8_MMA(1, 1, At, B1); PG8_BAR;
            }
        }
        if constexpr (ALIGN_EPI) { if (wr == 0) PG8_BAR; }
        E(acc, cur, wr, wc, fr, fq);
        if (!has_next) break;
#pragma unroll
        for (int a = 0; a < 2; ++a)
#pragma unroll
            for (int b = 0; b < 2; ++b)
#pragma unroll
                for (int m = 0; m < 4; ++m)
#pragma unroll
                    for (int n = 0; n < 2; ++n) acc[a][b][m][n] = (f32x4){0.f, 0.f, 0.f, 0.f};
        cur = nxt; cA = nA; cB = nB; ++ui;
        if constexpr (ALIGN_EPI) { if (wr == 1) PG8_BAR; }
    }
    PG8_WAIT_V(0);
    if constexpr (!ALIGN_EPI) { if (wr == 0) PG8_BAR; }
    PG8_BAR;
#undef PG8_SA
#undef PG8_SB
#undef PG8_STAGE
#undef PG8_LDA
#undef PG8_LDB
#undef PG8_MMA
#undef PG8_WAIT_V
#undef PG8_WAIT_L
#undef PG8_BAR
#undef PG8_SCHED
}
}


#define XB_TMO      128
#define XB_XCNT(j)  (256  + 64 * (j))
#define XB_XSUB(j)  (1280 + 64 * (j))
#define XB_XGEN(j)  (2304 + 64 * (j))
#define XB_TOP      3328
#define XB_TOPGEN   3392
#define XCD_BAR_WORDS 3456
#define XB_SPIN_CAP (1u << 18)
__device__ __forceinline__ unsigned xb_ld(unsigned* p)              { return __hip_atomic_load(p, __ATOMIC_RELAXED, __HIP_MEMORY_SCOPE_AGENT); }
__device__ __forceinline__ unsigned xb_add(unsigned* p, unsigned v) { return __hip_atomic_fetch_add(p, v, __ATOMIC_RELAXED, __HIP_MEMORY_SCOPE_AGENT); }
__device__ __forceinline__ unsigned xb_xcc_id() { return (unsigned)__builtin_amdgcn_s_getreg((3 << 11) | 20) & 0xFu; }
#define XB_SPIN(cond, bar) do { unsigned _sp = 0; while (cond) { __builtin_amdgcn_s_sleep(1); \
    if ((++_sp & 255u) == 0u) { if (xb_ld(&(bar)[XB_TMO])) break; if (_sp > XB_SPIN_CAP) { atomicAdd(&(bar)[XB_TMO], 1u); break; } } } } while (0)
struct XcdBarrier { unsigned* bar; unsigned x; volatile LAS unsigned* st; };
__device__ __forceinline__ XcdBarrier xcd_barrier_post(unsigned* bar, volatile LAS unsigned* st) {
    XcdBarrier b; b.bar = bar; b.x = xb_xcc_id(); b.st = st;
    if (threadIdx.x == 0) (void)xb_add(&bar[XB_XCNT(b.x)], 1u);
    return b;
}
__device__ __forceinline__ void xcd_barrier_complete(unsigned* bar, unsigned x, unsigned& nloc, unsigned& nx) {
    const unsigned G = gridDim.x * gridDim.y * gridDim.z;
    unsigned sum, cnt, mine, sp = 0u;
    for (;;) {
        sum = 0u; cnt = 0u; mine = 0u;
#pragma unroll
        for (unsigned j = 0; j < 16; ++j) { const unsigned c = xb_ld(&bar[XB_XCNT(j)]); sum += c; cnt += (c > 0u) ? 1u : 0u; mine = (j == x) ? c : mine; }
        if (sum == G) break;
        __builtin_amdgcn_s_sleep(1);
        if ((++sp & 255u) == 0u) { if (xb_ld(&bar[XB_TMO])) break; if (sp > XB_SPIN_CAP) { atomicAdd(&bar[XB_TMO], 1u); break; } }
    }
    nloc = mine > 0u ? mine : 1u; nx = cnt > 0u ? cnt : 1u;
}
__device__ __forceinline__ void xcd_barrier(const XcdBarrier& b) {
    asm volatile("s_waitcnt vmcnt(0)" ::: "memory");
    __syncthreads();
    if (threadIdx.x == 0) {
        unsigned* bar = b.bar;
        __builtin_amdgcn_s_waitcnt(0);
        unsigned nloc = b.st[0], nx = b.st[1];
        if (nloc == 0u) { xcd_barrier_complete(bar, b.x, nloc, nx); b.st[0] = nloc; b.st[1] = nx; }
        const unsigned old = xb_add(&bar[XB_XSUB(b.x)], 1u);
        const unsigned gen = old / nloc;
        if (old + 1u == (gen + 1u) * nloc) {
            __builtin_amdgcn_fence(__ATOMIC_RELEASE, "agent");
            asm volatile("s_waitcnt vmcnt(0)" ::: "memory");
            const unsigned og = xb_add(&bar[XB_TOP], 1u);
            const unsigned tg = og / nx;
            if (og + 1u == (tg + 1u) * nx) xb_add(&bar[XB_TOPGEN], 1u);
            else XB_SPIN(xb_ld(&bar[XB_TOPGEN]) == tg, bar);
            __builtin_amdgcn_fence(__ATOMIC_ACQUIRE, "agent");
            xb_add(&bar[XB_XGEN(b.x)], 1u);
            asm volatile("s_waitcnt vmcnt(0)" ::: "memory");
        } else {
            XB_SPIN(xb_ld(&bar[XB_XGEN(b.x)]) == gen, bar);
            __builtin_amdgcn_fence(__ATOMIC_ACQUIRE, "agent");
            asm volatile("s_waitcnt vmcnt(0)" ::: "memory");
        }
    }
    __syncthreads();
}

struct Args {
    const float *x, *c, *w_ada, *b_ada, *norm1_w, *w_in, *w_gate_up, *b_gate, *gla_norm_w, *conv_w, *w_proj_a, *w_proj_b, *w_out, *norm2_w, *w_mlp1, *w_mlp2, *final_norm_w;
    float* out; unsigned char* ws; int ph_lo, ph_hi;
};

#define LDS_WAIT() asm volatile("s_waitcnt lgkmcnt(0)" ::: "memory")

__device__ __forceinline__ void p0_mod(const Args& a, float* mod, int gw, int NGW, int lane) {
    for (int it = gw; it < 24 * 64; it += NGW) {
        const int cb = it % 24, kc = it / 24, col = cb * 256 + lane * 4, k0 = kc * 16;
        f32x4 s0 = {0.f, 0.f, 0.f, 0.f}, s1 = s0, s2 = s0, s3 = s0;
#pragma unroll
        for (int kk = 0; kk < 16; ++kk) {
            const f32x4 w = *(const f32x4*)(a.w_ada + (size_t)(k0 + kk) * NMOD + col);
            const float c0 = a.c[0 * D + k0 + kk], c1 = a.c[1 * D + k0 + kk], c2 = a.c[2 * D + k0 + kk], c3 = a.c[3 * D + k0 + kk];
            s0 += w * (c0 * sigmoidf_(c0)); s1 += w * (c1 * sigmoidf_(c1)); s2 += w * (c2 * sigmoidf_(c2)); s3 += w * (c3 * sigmoidf_(c3));
        }
        if (kc == 0) { const f32x4 bv = *(const f32x4*)(a.b_ada + col); s0 += bv; s1 += bv; s2 += bv; s3 += bv; }
#pragma unroll
        for (int e = 0; e < 4; ++e) { atomicAdd(mod + 0 * NMOD + col + e, s0[e]); atomicAdd(mod + 1 * NMOD + col + e, s1[e]); atomicAdd(mod + 2 * NMOD + col + e, s2[e]); atomicAdd(mod + 3 * NMOD + col + e, s3[e]); }
    }
}
__device__ __forceinline__ void tr_item(const float* W, int ldw, int k0, int sc0, bf16_t* WT, int ldd, int dr0, int dk0, LAS float* scr, int lane) {
#pragma unroll 8
    for (int i = 0; i < 32; ++i) { const int kk = 2 * i + (lane >> 5); scr[kk * 33 + (lane & 31)] = W[(size_t)(k0 + kk) * ldw + sc0 + (lane & 31)]; }
    LDS_WAIT(); asm volatile("" ::: "memory");
    const int c = lane & 7;
#pragma unroll
    for (int j = 0; j < 4; ++j) { const int n = (lane >> 3) + 8 * j; const LAS float* s = scr + (8 * c) * 33 + n;
        u32x4 o; o.x = pk2(s[0 * 33], s[1 * 33]); o.y = pk2(s[2 * 33], s[3 * 33]); o.z = pk2(s[4 * 33], s[5 * 33]); o.w = pk2(s[6 * 33], s[7 * 33]);
        *(u32x4*)(WT + (size_t)(dr0 + n) * ldd + dk0 + k0 + 8 * c) = o; }
    LDS_WAIT(); asm volatile("" ::: "memory");
}
__device__ __forceinline__ void p0_weights(const Args& a, LAS unsigned char* lds, int gw, int NGW, int wave, int lane) {
    LAS float* scr = (LAS float*)(lds + wave * 16384);
    unsigned char* ws = a.ws;
    bf16_t* W1A = (bf16_t*)(ws + WS_W1A); bf16_t* W1B = (bf16_t*)(ws + WS_W1B); bf16_t* WAB = (bf16_t*)(ws + WS_WAB);
    bf16_t* WOUT = (bf16_t*)(ws + WS_WOUT); bf16_t* WM1 = (bf16_t*)(ws + WS_WM1); bf16_t* WM2 = (bf16_t*)(ws + WS_WM2);
    constexpr int I_IN = 16 * 256, I_SQ = 16 * 32, I_M1 = 16 * 128, I_M2 = 64 * 32;
    constexpr int NITEMS = I_IN + 3 * I_SQ + I_M1 + I_M2;
    for (int it = gw; it < NITEMS; it += NGW) {
        int r = it;
        if (r < I_IN) { const int kb = r / 256, cbk = r % 256;
            if (cbk < 96) tr_item(a.w_in, INW, 64 * kb, 32 * cbk, W1A, D, 32 * cbk, 0, scr, lane);
            else { const int e = 32 * (cbk - 96), gi = e >> 10, ch = e & 1023; int dr;
                if (gi == 0) dr = ch; else if (gi == 1) dr = 1024 + 256 * (ch >> 7) + (ch & 127); else if (gi == 2) dr = 1024 + 256 * (ch >> 7) + 128 + (ch & 127); else if (gi == 3) dr = 3072 + ch; else dr = 4096 + ch;
                tr_item(a.w_in, INW, 64 * kb, REST_COL + e, W1B, D, dr, 0, scr, lane); }
            continue; } r -= I_IN;
        if (r < I_SQ) { tr_item(a.w_proj_a, D, 64 * (r / 32), 32 * (r % 32), WAB, 2 * D, 32 * (r % 32), 0, scr, lane); continue; } r -= I_SQ;
        if (r < I_SQ) { tr_item(a.w_proj_b, D, 64 * (r / 32), 32 * (r % 32), WAB, 2 * D, 32 * (r % 32), D, scr, lane); continue; } r -= I_SQ;
        if (r < I_SQ) { tr_item(a.w_out, D, 64 * (r / 32), 32 * (r % 32), WOUT, D, 32 * (r % 32), 0, scr, lane); continue; } r -= I_SQ;
        if (r < I_M1) { tr_item(a.w_mlp1, FF, 64 * (r / 128), 32 * (r % 128), WM1, D, 32 * (r % 128), 0, scr, lane); continue; } r -= I_M1;
        tr_item(a.w_mlp2, D, 64 * (r / 32), 32 * (r % 32), WM2, FF, 32 * (r % 32), 0, scr, lane);
    }
}

template <bool WITH_LR>
__device__ __forceinline__ void norm_mod_rows(const Args& a, LAS unsigned char* lds, const float* X, const float* nw, const float* mod, int shift_off, int scale_off, bf16_t* H, float* LR, int G, int tid, int wave, int lane) {
    LAS float* wl = (LAS float*)lds;
    if (WITH_LR) {
        for (int i = tid; i < 16 * 1024; i += NTHR) { const int k = i >> 4, j = i & 15; wl[j * 1024 + k] = a.w_in[(size_t)k * INW + LR_COL + j]; }
        __syncthreads();
    }
    for (int rb = blockIdx.x; rb < M / 64; rb += G) {
        const int b = rb >> 6;
        f32x4 al[4], sh[4];
#pragma unroll
        for (int j = 0; j < 4; ++j) { const int k = 4 * lane + 256 * j; const f32x4 w = *(const f32x4*)(nw + k), sc = *(const f32x4*)(mod + (size_t)b * NMOD + scale_off + k);
            al[j] = w * (sc + 1.0f); sh[j] = *(const f32x4*)(mod + (size_t)b * NMOD + shift_off + k); }
        for (int r = wave; r < 64; r += NWAVES) {
            const int row = rb * 64 + r;
            const f32x4* xr = (const f32x4*)(X + (size_t)row * D) + lane;
            f32x4 v[4]; float ss = 0.f;
#pragma unroll
            for (int j = 0; j < 4; ++j) { v[j] = xr[64 * j]; ss += (v[j].x * v[j].x + v[j].y * v[j].y) + (v[j].z * v[j].z + v[j].w * v[j].w); }
            const float rstd = 1.0f / sqrtf(wave_sum(ss) * (1.0f / D) + EPS);
#pragma unroll
            for (int j = 0; j < 4; ++j) v[j] = v[j] * rstd * al[j] + sh[j];
            unsigned long long* o8 = (unsigned long long*)(H + (size_t)row * D) + lane;
#pragma unroll
            for (int j = 0; j < 4; ++j) o8[64 * j] = (unsigned long long)pk2(v[j].x, v[j].y) | ((unsigned long long)pk2(v[j].z, v[j].w) << 32);
            if (WITH_LR) {
                float mine = 0.f;
#pragma unroll 1
                for (int jj = 0; jj < 16; ++jj) { float p = 0.f;
#pragma unroll
                    for (int j = 0; j < 4; ++j) { const f32x4 w = *(const LAS f32x4*)(wl + jj * 1024 + 4 * lane + 256 * j); p += (v[j].x * w.x + v[j].y * w.y) + (v[j].z * w.z + v[j].w * w.w); }
                    p = wave_sum(p); if (lane == jj) mine = p; }
                if (lane < 16) LR[(size_t)row * 16 + lane] = mine;
            }
        }
    }
}

__device__ __forceinline__ void gla_prep(const Args& a, LAS unsigned char* lds, bf16_t* R1, bf16_t* KET, float* DEC, const float* LR, int G, int tid) {
    const int d = tid & 127, seg = tid >> 7;
    LAS float* lrS = (LAS float*)lds;
    LAS float* segS = (LAS float*)(lds + 4096);
    for (int cu = blockIdx.x; cu < 1024; cu += G) {
        const int h = cu & 3, bc = cu >> 2, b = bc >> 6, c = bc & 63, row0 = b * SEQ + c * 64;
        if (tid < 256) { const f32x4 v = *(const f32x4*)(LR + (size_t)row0 * 16 + tid * 4); *(LAS f32x4*)(lrS + tid * 4) = v; }
        float wg[16];
#pragma unroll
        for (int r = 0; r < 16; ++r) wg[r] = a.w_gate_up[r * 512 + h * 128 + d];
        const float bgd = a.b_gate[h * 128 + d];
        bf16_t* qp = R1 + (size_t)(row0 + 16 * seg) * 3072 + h * 128 + d; bf16_t* kp = qp + 512;
        unsigned short qv[16], kv[16];
#pragma unroll
        for (int i = 0; i < 16; ++i) { qv[i] = qp[(size_t)i * 3072]; kv[i] = kp[(size_t)i * 3072]; }
        __syncthreads();
        float cum[16]; float run = 0.f;
#pragma unroll
        for (int i = 0; i < 16; ++i) { const int t = 16 * seg + i; float z = bgd;
#pragma unroll
            for (int r4 = 0; r4 < 4; ++r4) { const f32x4 l = *(const LAS f32x4*)(lrS + t * 16 + 4 * r4); z += (l.x * wg[4 * r4] + l.y * wg[4 * r4 + 1]) + (l.z * wg[4 * r4 + 2] + l.w * wg[4 * r4 + 3]); }
            const float ls = fminf(z, 0.f) - __logf(1.0f + __expf(-fabsf(z)));
            run += ls * (1.0f / 16.0f); cum[i] = run; }
        segS[seg * 128 + d] = run;
        __syncthreads();
        float pre = 0.f, tot = 0.f;
#pragma unroll
        for (int s2 = 0; s2 < 4; ++s2) { const float v = segS[s2 * 128 + d]; tot += v; if (s2 < seg) pre += v; }
        unsigned kee[8];
#pragma unroll
        for (int i = 0; i < 16; i += 2) {
            const float b0 = pre + cum[i], b1 = pre + cum[i + 1];
            const float q0 = bf2f(qv[i]) * __expf(b0) * 0.08838834764831845f, q1 = bf2f(qv[i + 1]) * __expf(b1) * 0.08838834764831845f;
            const float kf0 = bf2f(kv[i]), kf1 = bf2f(kv[i + 1]);
            qp[(size_t)i * 3072] = (bf16_t)f2bf(q0); qp[(size_t)(i + 1) * 3072] = (bf16_t)f2bf(q1);
            kp[(size_t)i * 3072] = (bf16_t)f2bf(kf0 * __expf(-b0)); kp[(size_t)(i + 1) * 3072] = (bf16_t)f2bf(kf1 * __expf(-b1));
            kee[i >> 1] = pk2(kf0 * __expf(tot - b0), kf1 * __expf(tot - b1));
        }
        u32x4* kep = (u32x4*)(KET + (size_t)cu * 8192 + d * 64 + 16 * seg);
        kep[0] = (u32x4){kee[0], kee[1], kee[2], kee[3]}; kep[1] = (u32x4){kee[4], kee[5], kee[6], kee[7]};
        if (seg == 0) DEC[(size_t)cu * 128 + d] = __expf(tot);
        __syncthreads();
    }
}

__device__ __forceinline__ void gla_main(LAS unsigned char* lds, const bf16_t* R1, const bf16_t* KET, const float* DEC, bf16_t* O, int G, int tid, int wave, int lane) {
    constexpr int OFF_QD = 0, OFF_KD = 17408, OFF_KE = 34816, OFF_VT = 53248, OFF_P = 55552, OFF_SB = 64768, OFF_DEC = 73472;
    const int fr = lane & 15, fq = lane >> 4;
    for (int unit = blockIdx.x; unit < 256; unit += G) {
        const int bh = unit >> 4, s = unit & 15, b = bh >> 2, h = bh & 3, j0 = s * 16;
        for (int i = tid; i < 2 * 16 * 272 / 4; i += NTHR) ((LAS unsigned*)(lds + OFF_SB))[i] = 0u;
        f32x4 Sacc[2]; Sacc[0] = (f32x4){0.f, 0.f, 0.f, 0.f}; Sacc[1] = Sacc[0];
        u32x4 rq[2], rk[2], re[2], rv = {0u, 0u, 0u, 0u}; float rdec = 0.f;
#define GLA_LOADC(cc) do { const int row0_ = b * SEQ + (cc) * 64; const size_t cu_ = (size_t)((b * 64 + (cc)) * 4 + h); \
        _Pragma("unroll") for (int i_ = 0; i_ < 2; ++i_) { const int p_ = tid + 512 * i_; \
            rq[i_] = *(const u32x4*)(R1 + (size_t)(row0_ + (p_ >> 4)) * 3072 + h * 128 + (p_ & 15) * 8); \
            rk[i_] = *(const u32x4*)(R1 + (size_t)(row0_ + (p_ >> 4)) * 3072 + 512 + h * 128 + (p_ & 15) * 8); \
            re[i_] = *(const u32x4*)(KET + cu_ * 8192 + (p_ >> 3) * 64 + (p_ & 7) * 8); } \
        if (tid < 128) rv = *(const u32x4*)(R1 + (size_t)(row0_ + (tid >> 1)) * 3072 + 1024 + h * 256 + j0 + 8 * (tid & 1)); \
        else if (tid < 256) rdec = DEC[cu_ * 128 + (tid - 128)]; } while (0)
        GLA_LOADC(0);
        for (int c = 0; c < 64; ++c) {
            const int row0 = b * SEQ + c * 64;
#pragma unroll
            for (int i = 0; i < 2; ++i) { const int p = tid + 512 * i;
                *(LAS u32x4*)(lds + OFF_QD + (p >> 4) * 272 + (p & 15) * 16) = rq[i];
                *(LAS u32x4*)(lds + OFF_KD + (p >> 4) * 272 + (p & 15) * 16) = rk[i];
                *(LAS u32x4*)(lds + OFF_KE + (p >> 3) * 144 + (p & 7) * 16) = re[i]; }
            if (tid < 128) { const int t = tid >> 1, hf = tid & 1; LAS unsigned short* vt = (LAS unsigned short*)(lds + OFF_VT);
#pragma unroll
                for (int e = 0; e < 4; ++e) { vt[(8 * hf + 2 * e) * 72 + t] = (unsigned short)(rv[e] & 0xffffu); vt[(8 * hf + 2 * e + 1) * 72 + t] = (unsigned short)(rv[e] >> 16); } }
            else if (tid < 256) ((LAS float*)(lds + OFF_DEC))[tid - 128] = rdec;
            if (c + 1 < 64) GLA_LOADC(c + 1);
            __syncthreads();
            { const int tm = wave >> 1;
#pragma unroll
              for (int q = 0; q < 2; ++q) { const int tn = 2 * (wave & 1) + q; f32x4 sa = {0.f, 0.f, 0.f, 0.f};
                if (tn <= tm) {
#pragma unroll
                    for (int ks = 0; ks < 4; ++ks) { const bf16x8 av = *(const LAS bf16x8*)(lds + OFF_QD + (16 * tm + fr) * 272 + (32 * ks + 8 * fq) * 2);
                        const bf16x8 bv = *(const LAS bf16x8*)(lds + OFF_KD + (16 * tn + fr) * 272 + (32 * ks + 8 * fq) * 2);
                        sa = __builtin_amdgcn_mfma_f32_16x16x32_bf16(av, bv, sa, 0, 0, 0); } }
                LAS unsigned short* pp = (LAS unsigned short*)(lds + OFF_P);
#pragma unroll
                for (int i = 0; i < 4; ++i) { const int t = 16 * tm + 4 * fq + i, sc = 16 * tn + fr; pp[t * 72 + sc] = (unsigned short)f2bf(sc <= t ? sa[i] : 0.f); } } }
            __syncthreads();
            const int cur = c & 1;
            if (wave < 4) { const int tm = wave; f32x4 o = {0.f, 0.f, 0.f, 0.f};
#pragma unroll
                for (int ks = 0; ks < 2; ++ks) { const bf16x8 av = *(const LAS bf16x8*)(lds + OFF_P + (16 * tm + fr) * 144 + (32 * ks + 8 * fq) * 2);
                    const bf16x8 bv = *(const LAS bf16x8*)(lds + OFF_VT + fr * 144 + (32 * ks + 8 * fq) * 2);
                    o = __builtin_amdgcn_mfma_f32_16x16x32_bf16(av, bv, o, 0, 0, 0); }
#pragma unroll
                for (int ks = 0; ks < 4; ++ks) { const bf16x8 av = *(const LAS bf16x8*)(lds + OFF_QD + (16 * tm + fr) * 272 + (32 * ks + 8 * fq) * 2);
                    const bf16x8 bv = *(const LAS bf16x8*)(lds + OFF_SB + cur * (16 * 272) + fr * 272 + (32 * ks + 8 * fq) * 2);
                    o = __builtin_amdgcn_mfma_f32_16x16x32_bf16(av, bv, o, 0, 0, 0); }
#pragma unroll
                for (int i = 0; i < 4; ++i) { const int t = 16 * tm + 4 * fq + i; O[(size_t)(row0 + t) * D + h * 256 + j0 + fr] = (bf16_t)f2bf(o[i]); }
            } else {
#pragma unroll
                for (int q = 0; q < 2; ++q) { const int dt = 2 * (wave - 4) + q; f32x4 sa = Sacc[q];
                    const f32x4 dv = *(const LAS f32x4*)(lds + OFF_DEC + (16 * dt + 4 * fq) * 4); sa = sa * dv;
#pragma unroll
                    for (int ks = 0; ks < 2; ++ks) { const bf16x8 av = *(const LAS bf16x8*)(lds + OFF_KE + (16 * dt + fr) * 144 + (32 * ks + 8 * fq) * 2);
                        const bf16x8 bv = *(const LAS bf16x8*)(lds + OFF_VT + fr * 144 + (32 * ks + 8 * fq) * 2);
                        sa = __builtin_amdgcn_mfma_f32_16x16x32_bf16(av, bv, sa, 0, 0, 0); }
                    Sacc[q] = sa;
                    *(LAS u32x2*)(lds + OFF_SB + (cur ^ 1) * (16 * 272) + fr * 272 + (16 * dt + 4 * fq) * 2) = (u32x2){pk2(sa[0], sa[1]), pk2(sa[2], sa[3])}; }
            }
            __syncthreads();
        }
#undef GLA_LOADC
    }
}

__device__ __forceinline__ void gla_post(const Args& a, const bf16_t* O, const bf16_t* R1, bf16_t* AAB, int gw, int NGW, int lane) {
    const f32x4 gw4 = *(const f32x4*)(a.gla_norm_w + 4 * lane);
    for (int row = gw; row < M; row += NGW) {
#pragma unroll
        for (int h = 0; h < 4; ++h) {
            const u32x2 ov = *(const u32x2*)(O + (size_t)row * D + h * 256 + 4 * lane);
            const u32x2 gv = *(const u32x2*)(R1 + (size_t)row * 3072 + 2048 + h * 256 + 4 * lane);
            const float o0 = bflo(ov.x), o1 = bfhi(ov.x), o2 = bflo(ov.y), o3 = bfhi(ov.y);
            const float rstd = 1.0f / sqrtf(wave_sum((o0 * o0 + o1 * o1) + (o2 * o2 + o3 * o3)) * (1.0f / 256.0f) + EPS);
            const float g0 = bflo(gv.x), g1 = bfhi(gv.x), g2 = bflo(gv.y), g3 = bfhi(gv.y);
            u32x2 w; w.x = pk2(o0 * rstd * gw4.x * (g0 * sigmoidf_(g0)), o1 * rstd * gw4.y * (g1 * sigmoidf_(g1)));
            w.y = pk2(o2 * rstd * gw4.z * (g2 * sigmoidf_(g2)), o3 * rstd * gw4.w * (g3 * sigmoidf_(g3)));
            *(u32x2*)(AAB + (size_t)row * 2048 + h * 256 + 4 * lane) = w;
        }
    }
}

__device__ __forceinline__ void conv_phase(const Args& a, const bf16_t* R2, bf16_t* AAB, int gw, int NGW, int lane) {
    const int ch = 16 * lane;
    float w0[16], w1[16], w2[16];
#pragma unroll
    for (int q = 0; q < 4; ++q) { const f32x4 x0 = *(const f32x4*)(a.conv_w + 0 * D + ch + 4 * q), x1 = *(const f32x4*)(a.conv_w + 1 * D + ch + 4 * q), x2 = *(const f32x4*)(a.conv_w + 2 * D + ch + 4 * q);
#pragma unroll
        for (int e = 0; e < 4; ++e) { w0[4 * q + e] = x0[e]; w1[4 * q + e] = x1[e]; w2[4 * q + e] = x2[e]; } }
    for (int rr = gw; rr < M / 8; rr += NGW) {
        const int t0 = rr * 8;
        u32x4 um2[2], um1[2];
        if ((t0 & (SEQ - 1)) == 0) { um2[0] = um2[1] = um1[0] = um1[1] = (u32x4){0u, 0u, 0u, 0u}; }
        else { const bf16_t* p2 = R2 + (size_t)(t0 - 2) * 4096 + 1024 + ch; const bf16_t* p1 = p2 + 4096;
            um2[0] = *(const u32x4*)p2; um2[1] = *(const u32x4*)(p2 + 8); um1[0] = *(const u32x4*)p1; um1[1] = *(const u32x4*)(p1 + 8); }
#pragma unroll
        for (int i = 0; i < 8; ++i) {
            const bf16_t* rp = R2 + (size_t)(t0 + i) * 4096;
            u32x4 u0[2], cb[2]; u0[0] = *(const u32x4*)(rp + 1024 + ch); u0[1] = *(const u32x4*)(rp + 1024 + ch + 8); cb[0] = *(const u32x4*)(rp + ch); cb[1] = *(const u32x4*)(rp + ch + 8);
            u32x4 ow[2];
#pragma unroll
            for (int hv = 0; hv < 2; ++hv)
#pragma unroll
                for (int q = 0; q < 4; ++q) { const int e = 8 * hv + 2 * q;
                    const float y0 = w0[e] * bflo(um2[hv][q]) + w1[e] * bflo(um1[hv][q]) + w2[e] * bflo(u0[hv][q]);
                    const float y1 = w0[e + 1] * bfhi(um2[hv][q]) + w1[e + 1] * bfhi(um1[hv][q]) + w2[e + 1] * bfhi(u0[hv][q]);
                    ow[hv][q] = pk2(bflo(cb[hv][q]) * y0, bfhi(cb[hv][q]) * y1); }
            bf16_t* op = AAB + (size_t)(t0 + i) * 2048 + 1024 + ch;
            *(u32x4*)op = ow[0]; *(u32x4*)(op + 8) = ow[1];
            um2[0] = um1[0]; um2[1] = um1[1]; um1[0] = u0[0]; um1[1] = u0[1];
        }
    }
}

__device__ __forceinline__ void final_norm(const Args& a, float* X, int gw, int NGW, int lane) {
    f32x4 w[4];
#pragma unroll
    for (int j = 0; j < 4; ++j) w[j] = *(const f32x4*)(a.final_norm_w + 4 * lane + 256 * j);
    for (int row = gw; row < M; row += NGW) {
        f32x4* xr = (f32x4*)(X + (size_t)row * D) + lane;
        f32x4 v[4]; float ss = 0.f;
#pragma unroll
        for (int j = 0; j < 4; ++j) { v[j] = xr[64 * j]; ss += (v[j].x * v[j].x + v[j].y * v[j].y) + (v[j].z * v[j].z + v[j].w * v[j].w); }
        const float rstd = 1.0f / sqrtf(wave_sum(ss) * (1.0f / D) + EPS);
#pragma unroll
        for (int j = 0; j < 4; ++j) xr[64 * j] = v[j] * rstd * w[j];
    }
}

__global__ void __launch_bounds__(NTHR, 2) fwd_megakernel(Args a) {
    extern __shared__ __attribute__((aligned(16))) unsigned char lds_raw[];
    LAS unsigned char* lds = (LAS unsigned char*)lds_raw;
    cg::grid_group grid = cg::this_grid();
    const int tid = threadIdx.x, lane = tid & 63, wave = __builtin_amdgcn_readfirstlane(tid >> 6);
    const int G = gridDim.x, gw = blockIdx.x * NWAVES + wave, NGW = G * NWAVES;
    unsigned char* ws = a.ws;
    float* mod = (float*)(ws + WS_MOD);
    bf16_t* W1A = (bf16_t*)(ws + WS_W1A); bf16_t* W1B = (bf16_t*)(ws + WS_W1B); bf16_t* WAB = (bf16_t*)(ws + WS_WAB);
    bf16_t* WOUT = (bf16_t*)(ws + WS_WOUT); bf16_t* WM1 = (bf16_t*)(ws + WS_WM1); bf16_t* WM2 = (bf16_t*)(ws + WS_WM2);
    float* LR = (float*)(ws + WS_LR); float* DEC = (float*)(ws + WS_DEC);
    bf16_t* R = (bf16_t*)(ws + WS_R); bf16_t* KET = (bf16_t*)(ws + WS_KET); bf16_t* AAB = (bf16_t*)(ws + WS_AAB);
    bf16_t* Hb = (bf16_t*)a.out; bf16_t* Ob = (bf16_t*)((unsigned char*)a.out + 32 * MiB);
    const int lo = a.ph_lo, hi = a.ph_hi;
    volatile LAS unsigned* bst = (volatile LAS unsigned*)(lds + 140000);
    if (tid < 2) bst[tid] = 0u;
    __syncthreads();
    const XcdBarrier bar = xcd_barrier_post((unsigned*)(ws + WS_BAR), bst);
    if (hi > 1000) grid.sync();
#ifndef PHASE_MASK
#define PHASE_MASK 0xffff
#endif
#define IN(k) (((PHASE_MASK >> (k)) & 1) && lo <= (k) && (k) < hi)
#define SEAM(k) do { if (IN(k) && IN((k) + 1)) xcd_barrier(bar); } while (0)

    if (IN(0)) { p0_mod(a, mod, gw, NGW, lane); p0_weights(a, lds, gw, NGW, wave, lane); }
    SEAM(0);
    if (IN(1)) { norm_mod_rows<true>(a, lds, a.x, a.norm1_w, mod, 0, D, Hb, LR, G, tid, wave, lane); __syncthreads(); }
    SEAM(1);
    if (IN(2)) { pg8::Gemm g{Hb, W1A, M, 3072, D, D}; pg8::StaticOrder S; S.init(M, 3072, G, (int)blockIdx.x);
        pg8::EpiBf16<0> E{R, 3072}; pg8::gemm_phase<pg8::EpiBf16<0>, pg8::StaticOrder, true, true>(lds, g, S, E); }
    SEAM(2);
    if (IN(3)) gla_prep(a, lds, R, KET, DEC, LR, G, tid);
    SEAM(3);
    if (IN(4)) gla_main(lds, R, KET, DEC, Ob, G, tid, wave, lane);
    SEAM(4);
    if (IN(5)) gla_post(a, Ob, R, AAB, gw, NGW, lane);
    SEAM(5);
    if (IN(6)) { pg8::Gemm g{Hb, W1B, M, 5120, D, D}; pg8::StaticOrder S; S.init(M, 5120, G, (int)blockIdx.x);
        pg8::EpiG1b E{R, 4096}; pg8::gemm_phase<pg8::EpiG1b, pg8::StaticOrder, true, true>(lds, g, S, E); }
    SEAM(6);
    if (IN(7)) conv_phase(a, R, AAB, gw, NGW, lane);
    SEAM(7);
    if (IN(8)) { pg8::Gemm g{AAB, WAB, M, D, 2 * D, 2 * D}; pg8::StaticOrder S; S.init(M, D, G, (int)blockIdx.x);
        pg8::EpiZ E{R + 2048, R + 3072, 4096, R + 1024, 4096}; pg8::gemm_phase<pg8::EpiZ, pg8::StaticOrder, false, true>(lds, g, S, E); }
    SEAM(8);
    if (IN(9)) { pg8::Gemm g{R + 1024, WOUT, M, D, D, 4096}; pg8::StaticOrder S; S.init(M, D, G, (int)blockIdx.x);
        pg8::EpiRes E{a.x, a.out, D, mod + 2 * D}; pg8::gemm_phase<pg8::EpiRes, pg8::StaticOrder, false, true>(lds, g, S, E); }
    SEAM(9);
    if (IN(10)) norm_mod_rows<false>(a, lds, a.out, a.norm2_w, mod, 3 * D, 4 * D, AAB, nullptr, G, tid, wave, lane);
    SEAM(10);
    if (IN(11)) { pg8::Gemm g{AAB, WM1, M, FF, D, D}; pg8::StaticOrder S; S.init(M, FF, G, (int)blockIdx.x);
        pg8::EpiBf16<1> E{R, FF}; pg8::gemm_phase<pg8::EpiBf16<1>, pg8::StaticOrder, true, true>(lds, g, S, E); }
    SEAM(11);
    if (IN(12)) { pg8::Gemm g{R, WM2, M, D, FF, FF}; pg8::StaticOrder S; S.init(M, D, G, (int)blockIdx.x);
        pg8::EpiRes E{a.out, a.out, D, mod + 5 * D}; pg8::gemm_phase<pg8::EpiRes, pg8::StaticOrder, false, true>(lds, g, S, E); }
    SEAM(12);
    if (IN(13)) final_norm(a, a.out, gw, NGW, lane);
#undef IN
#undef SEAM
}

extern "C" void kernel_launch(void* const* d_in, const int* in_sizes, int n_in, void* d_out, int out_size, void* d_ws, size_t ws_size, hipStream_t stream) {
    static int grid = 0;
    if (grid == 0) {
        if (n_in != 17 || in_sizes[0] != M * D || out_size != M * D || ws_size < WS_END) { fprintf(stderr, "kernel_launch: unexpected shapes (n_in %d, in0 %d, out %d, ws %zu)\n", n_in, n_in > 0 ? in_sizes[0] : -1, out_size, ws_size); grid = -1; return; }
        int dev = 0, cus = 0, per_cu = 0;
        if (hipGetDevice(&dev) != hipSuccess || hipDeviceGetAttribute(&cus, hipDeviceAttributeMultiprocessorCount, dev) != hipSuccess) { grid = -1; return; }
        if (hipFuncSetAttribute((const void*)fwd_megakernel, hipFuncAttributeMaxDynamicSharedMemorySize, LDS_BYTES) != hipSuccess) { fprintf(stderr, "kernel_launch: hipFuncSetAttribute failed\n"); grid = -1; return; }
        if (hipOccupancyMaxActiveBlocksPerMultiprocessor(&per_cu, (const void*)fwd_megakernel, NTHR, LDS_BYTES) != hipSuccess || per_cu < 1) { fprintf(stderr, "kernel_launch: occupancy query says %d\n", per_cu); per_cu = 1; }
        (void)hipGetLastError();
        grid = cus;
    }
    if (grid < 0) return;
    if (hipMemsetAsync((char*)d_ws + WS_CTL, 0, CTL_ZERO_BYTES, stream) != hipSuccess) { fprintf(stderr, "kernel_launch: memset failed\n"); return; }
    Args a{};
    const float** pp = (const float**)&a;
    for (int i = 0; i < 17; ++i) pp[i] = (const float*)d_in[i];
    a.out = (float*)d_out; a.ws = (unsigned char*)d_ws; a.ph_lo = 0; a.ph_hi = 14;
    void* args[] = {&a};
    hipError_t e = hipLaunchCooperativeKernel((const void*)fwd_megakernel, dim3(grid), dim3(NTHR), args, LDS_BYTES, stream);
    if (e != hipSuccess) fprintf(stderr, "kernel_launch: cooperative launch failed: %s (grid %d)\n", hipGetErrorString(e), grid);
}
```

```cpp
#include <hip/hip_runtime.h>
#include <hip/hip_cooperative_groups.h>
#include <cstdio>
#include <cstdint>
namespace cg = cooperative_groups;

#define LAS __attribute__((address_space(3)))
typedef unsigned short bf16_t;
typedef short bf16x8 __attribute__((ext_vector_type(8)));
typedef float f32x4 __attribute__((ext_vector_type(4)));
typedef float f32x2 __attribute__((ext_vector_type(2)));
typedef unsigned u32x4 __attribute__((ext_vector_type(4)));
typedef unsigned u32x2 __attribute__((ext_vector_type(2)));

constexpr int BATCH = 4, SEQ = 4096, D = 1024, M = BATCH * SEQ, FF = 4096, INW = 8208, NMOD = 6 * D;
constexpr int LR_COL = 3072;
constexpr int REST_COL = 3088;
constexpr float EPS = 1e-6f;
constexpr int NWAVES = 8, NTHR = 512;

constexpr size_t MiB = 1u << 20;
constexpr size_t WS_CTL = 0, CTL_ZERO_BYTES = 1 * MiB;
constexpr size_t WS_BAR = 16 * 1024;
constexpr size_t WS_MOD = 64 * 1024;
constexpr size_t WS_W1A = 2 * MiB;
constexpr size_t WS_W1B = 8 * MiB;
constexpr size_t WS_WAB = 18 * MiB;
constexpr size_t WS_WOUT = 22 * MiB;
constexpr size_t WS_WM1 = 24 * MiB;
constexpr size_t WS_WM2 = 32 * MiB;
constexpr size_t WS_LR = 40 * MiB;
constexpr size_t WS_DEC = 41 * MiB;
constexpr size_t WS_R = 48 * MiB;
constexpr size_t WS_KET = WS_R + 96 * MiB;
constexpr size_t WS_AAB = 176 * MiB;
constexpr size_t WS_END = 240 * MiB;

constexpr int LDS_BYTES = 147456;

__device__ __forceinline__ unsigned f2bf(float f) { unsigned u = __builtin_bit_cast(unsigned, f); return (u + 0x7fffu + ((u >> 16) & 1u)) >> 16; }
__device__ __forceinline__ unsigned pk2(float lo, float hi) { return f2bf(lo) | (f2bf(hi) << 16); }
__device__ __forceinline__ float bf2f(unsigned short v) { return __builtin_bit_cast(float, (unsigned)v << 16); }
__device__ __forceinline__ float bflo(unsigned w) { return __builtin_bit_cast(float, w << 16); }
__device__ __forceinline__ float bfhi(unsigned w) { return __builtin_bit_cast(float, w & 0xffff0000u); }
__device__ __forceinline__ float wave_sum(float v) {
#pragma unroll
    for (int o = 1; o < 64; o <<= 1) v += __shfl_xor(v, o);
    return v;
}
__device__ __forceinline__ float sigmoidf_(float v) { return 1.0f / (1.0f + __expf(-v)); }

namespace pg8 {
constexpr int BM = 256, BK = 64, HALF = 128, HTB = HALF * BK * 2, STAGE_BYTES = 8 * HTB, NXCD = 8, WGM = 8;
__host__ __device__ __forceinline__ int lds_byte(int r, int c) { const int st = (r >> 4) * 2 + (c >> 5), rr = r & 15, cc = c & 31, ob = rr * 64 + cc * 2; return st * 1024 + (ob ^ (((ob >> 9) & 1) << 5)); }
__host__ __device__ __forceinline__ void stage_rc(int b, int& R, int& C) { const int st = b / 1024, sb = b % 1024, swz = sb ^ (((sb >> 9) & 1) << 5); R = (st >> 1) * 16 + swz / 64; C = (st & 1) * 32 + (swz % 64) / 2; }
__host__ __device__ __forceinline__ int perm32(int rho) { const int n = rho >> 4, i = rho & 15; return 8 * (i >> 2) + 4 * n + (i & 3); }

struct Unit { int pm, pn; };
struct Gemm { const bf16_t* A; const bf16_t* Bt; int M, N, K, lda; };

struct StaticOrder {
    int nM, nN, nwg, G, c;
    __host__ __device__ void init(int M_, int N_, int G_, int c_) { nM = M_ / BM; nN = N_ / BM; nwg = nM * nN; G = G_; c = c_; }
    __host__ __device__ bool next(int i, Unit& u) const {
        const long L = (long)i * G + c; if (L >= nwg) return false;
        int wgid = (int)L; { const int q = nwg / NXCD, r = nwg % NXCD, xcd = wgid % NXCD, off = wgid / NXCD; wgid = (xcd < r ? xcd * (q + 1) : r * (q + 1) + (xcd - r) * q) + off; }
        const int nig = WGM * nN, gid = wgid / nig, fm = gid * WGM, gsz = (nM - fm) < WGM ? (nM - fm) : WGM;
        u.pm = fm + ((wgid % nig) % gsz); u.pn = (wgid % nig) / gsz; return true;
    }
};

__device__ __forceinline__ unsigned cvt_pk_bf16(float lo, float hi) { unsigned r; asm volatile("v_cvt_pk_bf16_f32 %0, %1, %2" : "=v"(r) : "v"(lo), "v"(hi)); return r; }

template <int ACT  > struct EpiBf16 {
    static constexpr bool PERM = true, HOOK = false;
    bf16_t* O; int ldc;
    __device__ __forceinline__ void hook(f32x4 (&)[2][2][4][2], const Unit&, int, int, int, int) const {}
    __device__ __forceinline__ void operator()(const f32x4 (&acc)[2][2][4][2], const Unit& u, int wr, int wc, int fr, int fq) const {
        int row0 = u.pm * BM + wr * 64 + fr; asm volatile("" : "+v"(row0)); const int col0 = u.pn * BM + wc * 32 + 8 * fq;
#pragma unroll
        for (int ai = 0; ai < 2; ++ai)
#pragma unroll
            for (int m = 0; m < 4; ++m) { bf16_t* rowp = O + (size_t)(row0 + ai * HALF + m * 16) * ldc + col0;
#pragma unroll
                for (int bj = 0; bj < 2; ++bj) { f32x4 v0 = acc[ai][bj][m][0], v1 = acc[ai][bj][m][1];
                    if (ACT == 1) {
#pragma unroll
                        for (int e = 0; e < 4; ++e) { float a0 = fmaxf(v0[e], 0.f), a1 = fmaxf(v1[e], 0.f); v0[e] = a0 * a0; v1[e] = a1 * a1; } }
                    u32x4 w; w.x = cvt_pk_bf16(v0[0], v0[1]); w.y = cvt_pk_bf16(v0[2], v0[3]); w.z = cvt_pk_bf16(v1[0], v1[1]); w.w = cvt_pk_bf16(v1[2], v1[3]);
                    *(u32x4*)(rowp + bj * HALF) = w; } }
    }
};
struct EpiG1b {
    static constexpr bool PERM = true, HOOK = false;
    bf16_t* O; int ldc;
    __device__ __forceinline__ void hook(f32x4 (&)[2][2][4][2], const Unit&, int, int, int, int) const {}
    __device__ __forceinline__ void operator()(const f32x4 (&acc)[2][2][4][2], const Unit& u, int wr, int wc, int fr, int fq) const {
        int row0 = u.pm * BM + wr * 64 + fr; asm volatile("" : "+v"(row0));
        if (u.pn >= 4 && u.pn < 12) {
            const int col0 = 1024 + (u.pn - 4) * 128 + wc * 32 + 8 * fq;
#pragma unroll
            for (int ai = 0; ai < 2; ++ai)
#pragma unroll
                for (int m = 0; m < 4; ++m) { bf16_t* rowp = O + (size_t)(row0 + ai * HALF + m * 16) * ldc + col0;
                    const f32x4 v0 = acc[ai][0][m][0] * acc[ai][1][m][0], v1 = acc[ai][0][m][1] * acc[ai][1][m][1];
                    u32x4 w; w.x = cvt_pk_bf16(v0[0], v0[1]); w.y = cvt_pk_bf16(v0[2], v0[3]); w.z = cvt_pk_bf16(v1[0], v1[1]); w.w = cvt_pk_bf16(v1[2], v1[3]);
                    *(u32x4*)rowp = w; }
        } else {
            const int colt = (u.pn < 4) ? u.pn * 256 : 2048 + (u.pn - 12) * 256; const int col0 = colt + wc * 32 + 8 * fq;
#pragma unroll
            for (int ai = 0; ai < 2; ++ai)
#pragma unroll
                for (int m = 0; m < 4; ++m) { bf16_t* rowp = O + (size_t)(row0 + ai * HALF + m * 16) * ldc + col0;
#pragma unroll
                    for (int bj = 0; bj < 2; ++bj) { const f32x4 v0 = acc[ai][bj][m][0], v1 = acc[ai][bj][m][1];
                        u32x4 w; w.x = cvt_pk_bf16(v0[0], v0[1]); w.y = cvt_pk_bf16(v0[2], v0[3]); w.z = cvt_pk_bf16(v1[0], v1[1]); w.w = cvt_pk_bf16(v1[2], v1[3]);
                        *(u32x4*)(rowp + bj * HALF) = w; } }
        }
    }
};
struct EpiZ {
    static constexpr bool PERM = true, HOOK = true;
    const bf16_t* GA; const bf16_t* GB; int ldg; bf16_t* Z; int ldz;
    __device__ __forceinline__ void hook(f32x4 (&acc)[2][2][4][2], const Unit& u, int wr, int wc, int fr, int fq) const {
        int row0 = u.pm * BM + wr * 64 + fr; asm volatile("" : "+v"(row0)); const int col0 = u.pn * BM + wc * 32 + 8 * fq;
#pragma unroll
        for (int ai = 0; ai < 2; ++ai)
#pragma unroll
            for (int m = 0; m < 4; ++m) { const size_t ro = (size_t)(row0 + ai * HALF + m * 16) * ldg + col0;
#pragma unroll
                for (int bj = 0; bj < 2; ++bj) { const u32x4 a = *(const u32x4*)(GA + ro + bj * HALF), b = *(const u32x4*)(GB + ro + bj * HALF);
#pragma unroll
                    for (int q = 0; q < 4; ++q) { const float ga0 = bflo(a[q]), ga1 = bfhi(a[q]), gb0 = bflo(b[q]), gb1 = bfhi(b[q]);
                        const float r0 = (1.0f + __expf(-gb0)) / (1.0f + __expf(-ga0)), r1 = (1.0f + __expf(-gb1)) / (1.0f + __expf(-ga1));
                        acc[ai][bj][m][q >> 1][(q & 1) * 2] *= r0; acc[ai][bj][m][q >> 1][(q & 1) * 2 + 1] *= r1; } }
                asm volatile("" ::: "memory"); }
    }
    __device__ __forceinline__ void operator()(const f32x4 (&acc)[2][2][4][2], const Unit& u, int wr, int wc, int fr, int fq) const {
        int row0 = u.pm * BM + wr * 64 + fr; asm volatile("" : "+v"(row0)); const int col0 = u.pn * BM + wc * 32 + 8 * fq;
#pragma unroll
        for (int ai = 0; ai < 2; ++ai)
#pragma unroll
            for (int m = 0; m < 4; ++m) { const size_t ro = (size_t)(row0 + ai * HALF + m * 16) * ldg + col0; bf16_t* zp = Z + (size_t)(row0 + ai * HALF + m * 16) * ldz + col0;
#pragma unroll
                for (int bj = 0; bj < 2; ++bj) { const u32x4 b = *(const u32x4*)(GB + ro + bj * HALF); u32x4 w;
#pragma unroll
                    for (int q = 0; q < 4; ++q) { const float s0 = sigmoidf_(bflo(b[q])), s1 = sigmoidf_(bfhi(b[q]));
                        w[q] = cvt_pk_bf16(acc[ai][bj][m][q >> 1][(q & 1) * 2] * s0, acc[ai][bj][m][q >> 1][(q & 1) * 2 + 1] * s1); }
                    *(u32x4*)(zp + bj * HALF) = w; }
                asm volatile("" ::: "memory"); }
    }
};
struct EpiRes {
    static constexpr bool PERM = false, HOOK = false;
    const float* base; float* out; int ldc; const float* gate;
    __device__ __forceinline__ void hook(f32x4 (&)[2][2][4][2], const Unit&, int, int, int, int) const {}
    __device__ __forceinline__ void operator()(const f32x4 (&acc)[2][2][4][2], const Unit& u, int wr, int wc, int fr, int fq) const {
        int row0 = u.pm * BM + wr * 64 + fr; asm volatile("" : "+v"(row0)); const int col0 = u.pn * BM + wc * 32 + 4 * fq; const int b = u.pm >> 4;
        f32x4 gv[2][2];
#pragma unroll
        for (int bj = 0; bj < 2; ++bj)
#pragma unroll
            for (int n = 0; n < 2; ++n) gv[bj][n] = *(const f32x4*)(gate + (size_t)b * NMOD + col0 + bj * HALF + n * 16);
#pragma unroll
        for (int ai = 0; ai < 2; ++ai)
#pragma unroll
            for (int m = 0; m < 4; ++m) { const size_t off = (size_t)(row0 + ai * HALF + m * 16) * ldc + col0;
#pragma unroll
                for (int bj = 0; bj < 2; ++bj)
#pragma unroll
                    for (int n = 0; n < 2; ++n) { const f32x4 bs = *(const f32x4*)(base + off + bj * HALF + n * 16);
                        *(f32x4*)(out + off + bj * HALF + n * 16) = bs + gv[bj][n] * acc[ai][bj][m][n]; } }
    }
};

template <class Epi, class Sched, bool ALIGN_EPI = false, bool SP2 = false>
__device__ __forceinline__ void gemm_phase(LAS unsigned char* lds, const Gemm g, const Sched& S, const Epi& E) {
    const int tid = threadIdx.x, wid = __builtin_amdgcn_readfirstlane(tid >> 6), lane = tid & 63, wr = wid >> 2, wc = wid & 3, fr = lane & 15, fq = lane >> 4;
    const int K = g.K, nt = K / BK, lda = g.lda;
    unsigned voffA[2], voffB[2];
#pragma unroll
    for (int i = 0; i < 2; ++i) { int R, C; stage_rc(tid * 16 + i * 8192, R, C); const int Rb = Epi::PERM ? ((R & ~31) + perm32(R & 31)) : R;
        voffA[i] = (unsigned)(R * lda + C) * 2u; voffB[i] = (unsigned)(Rb * K + C) * 2u; }
    const size_t kstep = (size_t)(BK * 2);
    const size_t hstepA = (size_t)HALF * lda * 2, hstepB = (size_t)HALF * K * 2;
    const size_t tstepA = 2 * hstepA, tstepB = 2 * hstepB;
    const unsigned ldsw = (unsigned)wid * 1024u;
    const int aoff = lds_byte(wr * 64 + fr, fq * 8), boff = lds_byte(wc * 32 + fr, fq * 8);
#define PG8_SA(b, h) (((b) * 2 + (h)) * HTB)
#define PG8_SB(b, h) ((4 + (b) * 2 + (h)) * HTB)
#define PG8_STAGE(bufoff, gbase, voff) do { _Pragma("unroll") for (int _i = 0; _i < 2; ++_i) \
        __builtin_amdgcn_global_load_lds((const unsigned*)((const char*)(gbase) + (voff)[_i]), (LAS unsigned*)(lds + (bufoff) + ldsw + _i * 8192), 16, 0, 0); } while (0)
#define PG8_LDA(dst, b, h) do { _Pragma("unroll") for (int m = 0; m < 4; ++m) _Pragma("unroll") for (int k = 0; k < 2; ++k) dst[m][k] = *(const LAS bf16x8*)(lds + PG8_SA(b, h) + aoff + m * 2048 + k * 1024); } while (0)
#define PG8_LDB(dst, b, h) do { _Pragma("unroll") for (int n = 0; n < 2; ++n) _Pragma("unroll") for (int k = 0; k < 2; ++k) dst[n][k] = *(const LAS bf16x8*)(lds + PG8_SB(b, h) + boff + n * 2048 + k * 1024); } while (0)
#define PG8_MMA(ai, bj, At, Bt) do { __builtin_amdgcn_s_setprio(1); _Pragma("unroll") for (int m = 0; m < 4; ++m) _Pragma("unroll") for (int n = 0; n < 2; ++n) _Pragma("unroll") for (int k = 0; k < 2; ++k) \
        acc[ai][bj][m][n] = __builtin_amdgcn_mfma_f32_16x16x32_bf16(Bt[n][k], At[m][k], acc[ai][bj][m][n], 0, 0, 0); __builtin_amdgcn_s_setprio(0); } while (0)
#define PG8_WAIT_V(n) asm volatile("s_waitcnt vmcnt(" #n ")" ::: "memory")
#define PG8_WAIT_L(n) asm volatile("s_waitcnt lgkmcnt(" #n ")" ::: "memory")
#define PG8_BAR __builtin_amdgcn_s_barrier()
#define PG8_SCHED __builtin_amdgcn_sched_barrier(0)
    Unit cur, nxt; int ui = 0;
    if (!S.next(0, cur)) return;
    f32x4 acc[2][2][4][2];
#pragma unroll
    for (int a = 0; a < 2; ++a)
#pragma unroll
        for (int b = 0; b < 2; ++b)
#pragma unroll
            for (int m = 0; m < 4; ++m)
#pragma unroll
                for (int n = 0; n < 2; ++n) acc[a][b][m][n] = (f32x4){0.f, 0.f, 0.f, 0.f};
    bf16x8 At[4][2], B0[2][2], B1[2][2];
    const char* cA = (const char*)g.A + (size_t)cur.pm * tstepA; const char* cB = (const char*)g.Bt + (size_t)cur.pn * tstepB;
    if constexpr (SP2) {
        PG8_STAGE(PG8_SB(0, 0), cB, voffB); PG8_STAGE(PG8_SB(0, 1), cB + hstepB, voffB); PG8_STAGE(PG8_SA(0, 0), cA, voffA); PG8_STAGE(PG8_SA(0, 1), cA + hstepA, voffA);
        if (wr == 1) PG8_BAR;
        PG8_WAIT_V(2); PG8_BAR;
        PG8_STAGE(PG8_SB(1, 0), cB + kstep, voffB); PG8_STAGE(PG8_SA(1, 0), cA + kstep, voffA); PG8_STAGE(PG8_SB(1, 1), cB + hstepB + kstep, voffB);
        PG8_WAIT_V(6); PG8_BAR;
    } else {
        PG8_STAGE(PG8_SB(0, 0), cB, voffB); PG8_STAGE(PG8_SA(0, 0), cA, voffA); PG8_STAGE(PG8_SB(0, 1), cB + hstepB, voffB); PG8_STAGE(PG8_SA(0, 1), cA + hstepA, voffA);
        if (wr == 1) PG8_BAR;
        PG8_WAIT_V(4); PG8_BAR;
        PG8_STAGE(PG8_SB(1, 0), cB + kstep, voffB); PG8_STAGE(PG8_SA(1, 0), cA + kstep, voffA); PG8_STAGE(PG8_SB(1, 1), cB + hstepB + kstep, voffB);
        PG8_WAIT_V(6); PG8_BAR;
    }
    for (;;) {
        const bool has_next = S.next(ui + 1, nxt);
        const char* nA = has_next ? (const char*)g.A + (size_t)nxt.pm * tstepA : cA; const char* nB = has_next ? (const char*)g.Bt + (size_t)nxt.pn * tstepB : cB;
        for (int t = 0; t < nt; t += 2) {
            const bool last = (t == nt - 2);
            const char* a1 = cA + (size_t)(t + 1) * kstep;
            const char* a2 = last ? nA : cA + (size_t)(t + 2) * kstep; const char* b2 = last ? nB : cB + (size_t)(t + 2) * kstep;
            const char* a3 = a2 + kstep; const char* b3 = b2 + kstep;
            if constexpr (Epi::HOOK) { if (t == (nt >> 1)) { E.hook(acc, cur, wr, wc, fr, fq); asm volatile("" ::: "memory"); } }
            if constexpr (SP2) {
            PG8_LDB(B0, 0, 0); PG8_LDB(B1, 0, 1); PG8_SCHED; PG8_LDA(At, 0, 0); PG8_STAGE(PG8_SA(1, 1), a1 + hstepA, voffA);
            PG8_WAIT_V(8); PG8_WAIT_L(0); PG8_BAR; PG8_MMA(0, 0, At, B0); PG8_MMA(0, 1, At, B1); PG8_BAR; PG8_SCHED;
            PG8_LDA(At, 0, 1); PG8_STAGE(PG8_SB(0, 0), b2, voffB); PG8_STAGE(PG8_SB(0, 1), b2 + hstepB, voffB); PG8_STAGE(PG8_SA(0, 0), a2, voffA);
            PG8_WAIT_V(8); PG8_WAIT_L(0); PG8_BAR; PG8_MMA(1, 0, At, B0); PG8_MMA(1, 1, At, B1); PG8_BAR; PG8_SCHED;
            PG8_LDB(B0, 1, 0); PG8_LDB(B1, 1, 1); PG8_SCHED; PG8_LDA(At, 1, 0); PG8_STAGE(PG8_SA(0, 1), a2 + hstepA, voffA);
            PG8_WAIT_V(8); PG8_WAIT_L(0); PG8_BAR; PG8_MMA(0, 0, At, B0); PG8_MMA(0, 1, At, B1); PG8_BAR; PG8_SCHED;
            PG8_LDA(At, 1, 1); PG8_STAGE(PG8_SB(1, 0), b3, voffB); PG8_STAGE(PG8_SB(1, 1), b3 + hstepB, voffB); PG8_STAGE(PG8_SA(1, 0), a3, voffA);
            PG8_WAIT_V(8); PG8_WAIT_L(0); PG8_BAR; PG8_MMA(1, 0, At, B0); PG8_MMA(1, 1, At, B1); PG8_BAR; PG8_SCHED;
            } else {
            PG8_LDB(B0, 0, 0); PG8_SCHED; PG8_LDA(At, 0, 0); PG8_STAGE(PG8_SA(1, 1), a1 + hstepA, voffA);
            PG8_WAIT_L(8); PG8_BAR; PG8_WAIT_L(0); PG8_MMA(0, 0, At, B0); PG8_BAR; PG8_SCHED;
            PG8_LDB(B1, 0, 1); PG8_STAGE(PG8_SB(0, 0), b2, voffB);
            PG8_BAR; PG8_WAIT_L(0); PG8_MMA(0, 1, At, B1); PG8_BAR;
            PG8_LDA(At, 0, 1); PG8_STAGE(PG8_SA(0, 0), a2, voffA);
            PG8_BAR; PG8_WAIT_L(0); PG8_MMA(1, 0, At, B0); PG8_BAR; PG8_SCHED;
            PG8_STAGE(PG8_SB(0, 1), b2 + hstepB, voffB);
            PG8_WAIT_V(6); PG8_BAR; PG8_MMA(1, 1, At, B1); PG8_BAR;
            PG8_LDB(B0, 1, 0); PG8_SCHED; PG8_LDA(At, 1, 0); PG8_STAGE(PG8_SA(0, 1), a2 + hstepA, voffA);
            PG8_WAIT_L(8); PG8_BAR; PG8_WAIT_L(0); PG8_MMA(0, 0, At, B0); PG8_BAR; PG8_SCHED;
            PG8_LDB(B1, 1, 1); PG8_STAGE(PG8_SB(1, 0), b3, voffB);
            PG8_BAR; PG8_WAIT_L(0); PG8_MMA(0, 1, At, B1); PG8_BAR;
            PG8_LDA(At, 1, 1); PG8_STAGE(PG8_SA(1, 0), a3, voffA);
            PG8_BAR; PG8_WAIT_L(0); PG8_MMA(1, 0, At, B0); PG8_BAR; PG8_SCHED;
            PG8_STAGE(PG8_SB(1, 1), b3 + hstepB, voffB);
            PG8_WAIT_V(6); PG8_BAR; PG8_MMA(1, 1, At, B1); PG8_BAR;
            }
        }
        if constexpr (ALIGN_EPI) { if (wr == 0) PG8_BAR; }
        E(acc, cur, wr, wc, fr, fq);
        if (!has_next) break;
#pragma unroll
        for (int a = 0; a < 2; ++a)
#pragma unroll
            for (int b = 0; b < 2; ++b)
#pragma unroll
                for (int m = 0; m < 4; ++m)
#pragma unroll
                    for (int n = 0; n < 2; ++n) acc[a][b][m][n] = (f32x4){0.f, 0.f, 0.f, 0.f};
        cur = nxt; cA = nA; cB = nB; ++ui;
        if constexpr (ALIGN_EPI) { if (wr == 1) PG8_BAR; }
    }
    PG8_WAIT_V(0);
    if constexpr (!ALIGN_EPI) { if (wr == 0) PG8_BAR; }
    PG8_BAR;
#undef PG8_SA
#undef PG8_SB
#undef PG8_STAGE
#undef PG8_LDA
#undef PG8_LDB
#undef PG8_MMA
#undef PG8_WAIT_V
#undef PG8_WAIT_L
#undef PG8_BAR
#undef PG8_SCHED
}
}


#define XB_TMO      128
#define XB_XCNT(j)  (256  + 64 * (j))
#define XB_XSUB(j)  (1280 + 64 * (j))
#define XB_XGEN(j)  (2304 + 64 * (j))
#define XB_TOP      3328
#define XB_TOPGEN   3392
#define XCD_BAR_WORDS 3456
#define XB_SPIN_CAP (1u << 18)
__device__ __forceinline__ unsigned xb_ld(unsigned* p)              { return __hip_atomic_load(p, __ATOMIC_RELAXED, __HIP_MEMORY_SCOPE_AGENT); }
__device__ __forceinline__ unsigned xb_add(unsigned* p, unsigned v) { return __hip_atomic_fetch_add(p, v, __ATOMIC_RELAXED, __HIP_MEMORY_SCOPE_AGENT); }
__device__ __forceinline__ unsigned xb_xcc_id() { return (unsigned)__builtin_amdgcn_s_getreg((3 << 11) | 20) & 0xFu; }
#define XB_SPIN(cond, bar) do { unsigned _sp = 0; while (cond) { __builtin_amdgcn_s_sleep(1); \
    if ((++_sp & 255u) == 0u) { if (xb_ld(&(bar)[XB_TMO])) break; if (_sp > XB_SPIN_CAP) { atomicAdd(&(bar)[XB_TMO], 1u); break; } } } } while (0)
struct XcdBarrier { unsigned* bar; unsigned x; volatile LAS unsigned* st; };
__device__ __forceinline__ XcdBarrier xcd_barrier_post(unsigned* bar, volatile LAS unsigned* st) {
    XcdBarrier b; b.bar = bar; b.x = xb_xcc_id(); b.st = st;
    if (threadIdx.x == 0) (void)xb_add(&bar[XB_XCNT(b.x)], 1u);
    return b;
}
__device__ __forceinline__ void xcd_barrier_complete(unsigned* bar, unsigned x, unsigned& nloc, unsigned& nx) {
    const unsigned G = gridDim.x * gridDim.y * gridDim.z;
    unsigned sum, cnt, mine, sp = 0u;
    for (;;) {
        sum = 0u; cnt = 0u; mine = 0u;
#pragma unroll
        for (unsigned j = 0; j < 16; ++j) { const unsigned c = xb_ld(&bar[XB_XCNT(j)]); sum += c; cnt += (c > 0u) ? 1u : 0u; mine = (j == x) ? c : mine; }
        if (sum == G) break;
        __builtin_amdgcn_s_sleep(1);
        if ((++sp & 255u) == 0u) { if (xb_ld(&bar[XB_TMO])) break; if (sp > XB_SPIN_CAP) { atomicAdd(&bar[XB_TMO], 1u); break; } }
    }
    nloc = mine > 0u ? mine : 1u; nx = cnt > 0u ? cnt : 1u;
}
__device__ __forceinline__ void xcd_barrier(const XcdBarrier& b) {
    asm volatile("s_waitcnt vmcnt(0)" ::: "memory");
    __syncthreads();
    if (threadIdx.x == 0) {
        unsigned* bar = b.bar;
        __builtin_amdgcn_s_waitcnt(0);
        unsigned nloc = b.st[0], nx = b.st[1];
        if (nloc == 0u) { xcd_barrier_complete(bar, b.x, nloc, nx); b.st[0] = nloc; b.st[1] = nx; }
        const unsigned old = xb_add(&bar[XB_XSUB(b.x)], 1u);
        const unsigned gen = old / nloc;
        if (old + 1u == (gen + 1u) * nloc) {
            __builtin_amdgcn_fence(__ATOMIC_RELEASE, "agent");
            asm volatile("s_waitcnt vmcnt(0)" ::: "memory");
            const unsigned og = xb_add(&bar[XB_TOP], 1u);
            const unsigned tg = og / nx;
            if (og + 1u == (tg + 1u) * nx) xb_add(&bar[XB_TOPGEN], 1u);
            else XB_SPIN(xb_ld(&bar[XB_TOPGEN]) == tg, bar);
            __builtin_amdgcn_fence(__ATOMIC_ACQUIRE, "agent");
            xb_add(&bar[XB_XGEN(b.x)], 1u);
            asm volatile("s_waitcnt vmcnt(0)" ::: "memory");
        } else {
            XB_SPIN(xb_ld(&bar[XB_XGEN(b.x)]) == gen, bar);
            __builtin_amdgcn_fence(__ATOMIC_ACQUIRE, "agent");
            asm volatile("s_waitcnt vmcnt(0)" ::: "memory");
        }
    }
    __syncthreads();
}

struct Args {
    const float *x, *c, *w_ada, *b_ada, *norm1_w, *w_in, *w_gate_up, *b_gate, *gla_norm_w, *conv_w, *w_proj_a, *w_proj_b, *w_out, *norm2_w, *w_mlp1, *w_mlp2, *final_norm_w;
    float* out; unsigned char* ws; int ph_lo, ph_hi;
};

#define LDS_WAIT() asm volatile("s_waitcnt lgkmcnt(0)" ::: "memory")

__device__ __forceinline__ void p0_mod(const Args& a, float* mod, int gw, int NGW, int lane) {
    for (int it = gw; it < 24 * 64; it += NGW) {
        const int cb = it % 24, kc = it / 24, col = cb * 256 + lane * 4, k0 = kc * 16;
        f32x4 s0 = {0.f, 0.f, 0.f, 0.f}, s1 = s0, s2 = s0, s3 = s0;
#pragma unroll
        for (int kk = 0; kk < 16; ++kk) {
            const f32x4 w = *(const f32x4*)(a.w_ada + (size_t)(k0 + kk) * NMOD + col);
            const float c0 = a.c[0 * D + k0 + kk], c1 = a.c[1 * D + k0 + kk], c2 = a.c[2 * D + k0 + kk], c3 = a.c[3 * D + k0 + kk];
            s0 += w * (c0 * sigmoidf_(c0)); s1 += w * (c1 * sigmoidf_(c1)); s2 += w * (c2 * sigmoidf_(c2)); s3 += w * (c3 * sigmoidf_(c3));
        }
        if (kc == 0) { const f32x4 bv = *(const f32x4*)(a.b_ada + col); s0 += bv; s1 += bv; s2 += bv; s3 += bv; }
#pragma unroll
        for (int e = 0; e < 4; ++e) { atomicAdd(mod + 0 * NMOD + col + e, s0[e]); atomicAdd(mod + 1 * NMOD + col + e, s1[e]); atomicAdd(mod + 2 * NMOD + col + e, s2[e]); atomicAdd(mod + 3 * NMOD + col + e, s3[e]); }
    }
}
__device__ __forceinline__ void tr_item(const float* W, int ldw, int k0, int sc0, bf16_t* WT, int ldd, int dr0, int dk0, LAS float* scr, int lane) {
#pragma unroll 8
    for (int i = 0; i < 32; ++i) { const int kk = 2 * i + (lane >> 5); scr[kk * 33 + (lane & 31)] = W[(size_t)(k0 + kk) * ldw + sc0 + (lane & 31)]; }
    LDS_WAIT(); asm volatile("" ::: "memory");
    const int c = lane & 7;
#pragma unroll
    for (int j = 0; j < 4; ++j) { const int n = (lane >> 3) + 8 * j; const LAS float* s = scr + (8 * c) * 33 + n;
        u32x4 o; o.x = pk2(s[0 * 33], s[1 * 33]); o.y = pk2(s[2 * 33], s[3 * 33]); o.z = pk2(s[4 * 33], s[5 * 33]); o.w = pk2(s[6 * 33], s[7 * 33]);
        *(u32x4*)(WT + (size_t)(dr0 + n) * ldd + dk0 + k0 + 8 * c) = o; }
    LDS_WAIT(); asm volatile("" ::: "memory");
}
__device__ __forceinline__ void p0_weights(const Args& a, LAS unsigned char* lds, int gw, int NGW, int wave, int lane) {
    LAS float* scr = (LAS float*)(lds + wave * 16384);
    unsigned char* ws = a.ws;
    bf16_t* W1A = (bf16_t*)(ws + WS_W1A); bf16_t* W1B = (bf16_t*)(ws + WS_W1B); bf16_t* WAB = (bf16_t*)(ws + WS_WAB);
    bf16_t* WOUT = (bf16_t*)(ws + WS_WOUT); bf16_t* WM1 = (bf16_t*)(ws + WS_WM1); bf16_t* WM2 = (bf16_t*)(ws + WS_WM2);
    constexpr int I_IN = 16 * 256, I_SQ = 16 * 32, I_M1 = 16 * 128, I_M2 = 64 * 32;
    constexpr int NITEMS = I_IN + 3 * I_SQ + I_M1 + I_M2;
    for (int it = gw; it < NITEMS; it += NGW) {
        int r = it;
        if (r < I_IN) { const int kb = r / 256, cbk = r % 256;
            if (cbk < 96) tr_item(a.w_in, INW, 64 * kb, 32 * cbk, W1A, D, 32 * cbk, 0, scr, lane);
            else { const int e = 32 * (cbk - 96), gi = e >> 10, ch = e & 1023; int dr;
                if (gi == 0) dr = ch; else if (gi == 1) dr = 1024 + 256 * (ch >> 7) + (ch & 127); else if (gi == 2) dr = 1024 + 256 * (ch >> 7) + 128 + (ch & 127); else if (gi == 3) dr = 3072 + ch; else dr = 4096 + ch;
                tr_item(a.w_in, INW, 64 * kb, REST_COL + e, W1B, D, dr, 0, scr, lane); }
            continue; } r -= I_IN;
        if (r < I_SQ) { tr_item(a.w_proj_a, D, 64 * (r / 32), 32 * (r % 32), WAB, 2 * D, 32 * (r % 32), 0, scr, lane); continue; } r -= I_SQ;
        if (r < I_SQ) { tr_item(a.w_proj_b, D, 64 * (r / 32), 32 * (r % 32), WAB, 2 * D, 32 * (r % 32), D, scr, lane); continue; } r -= I_SQ;
        if (r < I_SQ) { tr_item(a.w_out, D, 64 * (r / 32), 32 * (r % 32), WOUT, D, 32 * (r % 32), 0, scr, lane); continue; } r -= I_SQ;
        if (r < I_M1) { tr_item(a.w_mlp1, FF, 64 * (r / 128), 32 * (r % 128), WM1, D, 32 * (r % 128), 0, scr, lane); continue; } r -= I_M1;
        tr_item(a.w_mlp2, D, 64 * (r / 32), 32 * (r % 32), WM2, FF, 32 * (r % 32), 0, scr, lane);
    }
}

template <bool WITH_LR>
__device__ __forceinline__ void norm_mod_rows(const Args& a, LAS unsigned char* lds, const float* X, const float* nw, const float* mod, int shift_off, int scale_off, bf16_t* H, float* LR, int G, int tid, int wave, int lane) {
    LAS float* wl = (LAS float*)lds;
    if (WITH_LR) {
        for (int i = tid; i < 16 * 1024; i += NTHR) { const int k = i >> 4, j = i & 15; wl[j * 1024 + k] = a.w_in[(size_t)k * INW + LR_COL + j]; }
        __syncthreads();
    }
    for (int rb = blockIdx.x; rb < M / 64; rb += G) {
        const int b = rb >> 6;
        f32x4 al[4], sh[4];
#pragma unroll
        for (int j = 0; j < 4; ++j) { const int k = 4 * lane + 256 * j; const f32x4 w = *(const f32x4*)(nw + k), sc = *(const f32x4*)(mod + (size_t)b * NMOD + scale_off + k);
            al[j] = w * (sc + 1.0f); sh[j] = *(const f32x4*)(mod + (size_t)b * NMOD + shift_off + k); }
        for (int r = wave; r < 64; r += NWAVES) {
            const int row = rb * 64 + r;
            const f32x4* xr = (const f32x4*)(X + (size_t)row * D) + lane;
            f32x4 v[4]; float ss = 0.f;
#pragma unroll
            for (int j = 0; j < 4; ++j) { v[j] = xr[64 * j]; ss += (v[j].x * v[j].x + v[j].y * v[j].y) + (v[j].z * v[j].z + v[j].w * v[j].w); }
            const float rstd = 1.0f / sqrtf(wave_sum(ss) * (1.0f / D) + EPS);
#pragma unroll
            for (int j = 0; j < 4; ++j) v[j] = v[j] * rstd * al[j] + sh[j];
            unsigned long long* o8 = (unsigned long long*)(H + (size_t)row * D) + lane;
#pragma unroll
            for (int j = 0; j < 4; ++j) o8[64 * j] = (unsigned long long)pk2(v[j].x, v[j].y) | ((unsigned long long)pk2(v[j].z, v[j].w) << 32);
            if (WITH_LR) {
                float mine = 0.f;
#pragma unroll 1
                for (int jj = 0; jj < 16; ++jj) { float p = 0.f;
#pragma unroll
                    for (int j = 0; j < 4; ++j) { const f32x4 w = *(const LAS f32x4*)(wl + jj * 1024 + 4 * lane + 256 * j); p += (v[j].x * w.x + v[j].y * w.y) + (v[j].z * w.z + v[j].w * w.w); }
                    p = wave_sum(p); if (lane == jj) mine = p; }
                if (lane < 16) LR[(size_t)row * 16 + lane] = mine;
            }
        }
    }
}

#define GLA_BAR() do { asm volatile("s_waitcnt lgkmcnt(0)" ::: "memory"); __builtin_amdgcn_s_barrier(); asm volatile("" ::: "memory"); } while (0)
__device__ __forceinline__ void gla_prep(const Args& a, LAS unsigned char* lds, bf16_t* R1, bf16_t* KET, float* DEC, bf16_t* PG, const float* LR, int G, int tid, int wave, int lane) {
    constexpr int OFF_LR = 0, OFF_SEG = 4096, OFF_QD = 8192, OFF_KD = OFF_QD + 17408, OFF_PS = OFF_KD + 17408;
    const int d = tid & 127, seg = tid >> 7, fr = lane & 15, fq = lane >> 4;
    LAS float* lrS = (LAS float*)(lds + OFF_LR);
    LAS float* segS = (LAS float*)(lds + OFF_SEG);
    for (int cu = blockIdx.x; cu < 1024; cu += G) {
        const int h = cu & 3, bc = cu >> 2, b = bc >> 6, c = bc & 63, row0 = b * SEQ + c * 64;
        if (tid < 256) { const f32x4 v = *(const f32x4*)(LR + (size_t)row0 * 16 + tid * 4); *(LAS f32x4*)(lrS + tid * 4) = v; }
        float wg[16];
#pragma unroll
        for (int r = 0; r < 16; ++r) wg[r] = a.w_gate_up[r * 512 + h * 128 + d];
        const float bgd = a.b_gate[h * 128 + d];
        bf16_t* qp = R1 + (size_t)(row0 + 16 * seg) * 3072 + h * 128 + d; const bf16_t* kp = qp + 512;
        unsigned short qv[16], kv[16];
#pragma unroll
        for (int i = 0; i < 16; ++i) { qv[i] = qp[(size_t)i * 3072]; kv[i] = kp[(size_t)i * 3072]; }
        __syncthreads();
        float cum[16]; float run = 0.f;
#pragma unroll
        for (int i = 0; i < 16; ++i) { const int t = 16 * seg + i; float z = bgd;
#pragma unroll
            for (int r4 = 0; r4 < 4; ++r4) { const f32x4 l = *(const LAS f32x4*)(lrS + t * 16 + 4 * r4); z += (l.x * wg[4 * r4] + l.y * wg[4 * r4 + 1]) + (l.z * wg[4 * r4 + 2] + l.w * wg[4 * r4 + 3]); }
            const float ls = fminf(z, 0.f) - __logf(1.0f + __expf(-fabsf(z)));
            run += ls * (1.0f / 16.0f); cum[i] = run; }
        segS[seg * 128 + d] = run;
        __syncthreads();
        float pre = 0.f, tot = 0.f;
#pragma unroll
        for (int s2 = 0; s2 < 4; ++s2) { const float v = segS[s2 * 128 + d]; tot += v; if (s2 < seg) pre += v; }
        unsigned kee[8];
        LAS unsigned short* qdl = (LAS unsigned short*)(lds + OFF_QD); LAS unsigned short* kdl = (LAS unsigned short*)(lds + OFF_KD);
#pragma unroll
        for (int i = 0; i < 16; i += 2) {
            const float b0 = pre + cum[i], b1 = pre + cum[i + 1];
            const unsigned q0 = f2bf(bf2f(qv[i]) * __expf(b0) * 0.08838834764831845f), q1 = f2bf(bf2f(qv[i + 1]) * __expf(b1) * 0.08838834764831845f);
            const float kf0 = bf2f(kv[i]), kf1 = bf2f(kv[i + 1]);
            qp[(size_t)i * 3072] = (bf16_t)q0; qp[(size_t)(i + 1) * 3072] = (bf16_t)q1;
            qdl[(16 * seg + i) * 136 + d] = (unsigned short)q0; qdl[(16 * seg + i + 1) * 136 + d] = (unsigned short)q1;
            kdl[(16 * seg + i) * 136 + d] = (unsigned short)f2bf(kf0 * __expf(-b0)); kdl[(16 * seg + i + 1) * 136 + d] = (unsigned short)f2bf(kf1 * __expf(-b1));
            kee[i >> 1] = pk2(kf0 * __expf(tot - b0), kf1 * __expf(tot - b1));
        }
        u32x4* kep = (u32x4*)(KET + (size_t)cu * 8192 + d * 64 + 16 * seg);
        kep[0] = (u32x4){kee[0], kee[1], kee[2], kee[3]}; kep[1] = (u32x4){kee[4], kee[5], kee[6], kee[7]};
        if (seg == 0) DEC[(size_t)cu * 128 + d] = __expf(tot);
        GLA_BAR();
        { const int tm = wave >> 1;
#pragma unroll
          for (int q = 0; q < 2; ++q) { const int tn = 2 * (wave & 1) + q; f32x4 sa = {0.f, 0.f, 0.f, 0.f}, sb = {0.f, 0.f, 0.f, 0.f};
            if (tn <= tm) {
#pragma unroll
                for (int ks = 0; ks < 4; ++ks) { const bf16x8 av = *(const LAS bf16x8*)(lds + OFF_QD + (16 * tm + fr) * 272 + (32 * ks + 8 * fq) * 2);
                    const bf16x8 bv = *(const LAS bf16x8*)(lds + OFF_KD + (16 * tn + fr) * 272 + (32 * ks + 8 * fq) * 2);
                    if (ks & 1) sb = __builtin_amdgcn_mfma_f32_16x16x32_bf16(av, bv, sb, 0, 0, 0); else sa = __builtin_amdgcn_mfma_f32_16x16x32_bf16(av, bv, sa, 0, 0, 0); }
                sa = sa + sb; }
            LAS unsigned short* pp = (LAS unsigned short*)(lds + OFF_PS);
#pragma unroll
            for (int i = 0; i < 4; ++i) { const int t = 16 * tm + 4 * fq + i, sc = 16 * tn + fr; pp[t * 72 + sc] = (unsigned short)f2bf(sc <= t ? sa[i] : 0.f); } } }
        GLA_BAR();
        *(u32x4*)(PG + (size_t)cu * 4096 + (tid >> 3) * 64 + (tid & 7) * 8) = *(const LAS u32x4*)(lds + OFF_PS + (tid >> 3) * 144 + (tid & 7) * 16);
        GLA_BAR();
    }
}

struct GlaRegs { u32x4 f[6]; u32x4 rv; };
__device__ __forceinline__ void gla_load(GlaRegs& r, const bf16_t* R1, const bf16_t* KET, const float* DEC, const bf16_t* PG, int b, int h, int j0, int cc, int tid, int wave, int fr, int fq) {
    const int row0 = b * SEQ + cc * 64; const size_t cu = (size_t)((b * 64 + cc) * 4 + h);
    const u32x4* p0; const u32x4* p1; const u32x4* p2; const u32x4* p3; const u32x4* p4; const u32x4* p5;
    if (wave < 4) { const bf16_t* pb = PG + cu * 4096 + (16 * wave + fr) * 64 + 8 * fq; const bf16_t* qb = R1 + (size_t)(row0 + 16 * wave + fr) * 3072 + h * 128 + 8 * fq;
        p0 = (const u32x4*)pb; p1 = (const u32x4*)(pb + 32); p2 = (const u32x4*)qb; p3 = (const u32x4*)(qb + 32); p4 = (const u32x4*)(qb + 64); p5 = (const u32x4*)(qb + 96); }
    else { const int dt0 = 2 * (wave - 4); const bf16_t* kb = KET + cu * 8192 + (16 * dt0 + fr) * 64 + 8 * fq; const float* db = DEC + cu * 128 + 16 * dt0 + 4 * fq;
        p0 = (const u32x4*)kb; p1 = (const u32x4*)(kb + 32); p2 = (const u32x4*)(kb + 1024); p3 = (const u32x4*)(kb + 1024 + 32); p4 = (const u32x4*)db; p5 = (const u32x4*)(db + 16); }
    r.f[0] = *p0; r.f[1] = *p1; r.f[2] = *p2; r.f[3] = *p3; r.f[4] = *p4; r.f[5] = *p5;
    const int tv = tid & 127;
    r.rv = *(const u32x4*)(R1 + (size_t)(row0 + (tv >> 1)) * 3072 + 1024 + h * 256 + j0 + 8 * (tv & 1));
}
__device__ __forceinline__ void gla_chunk(LAS unsigned char* lds, GlaRegs& r, f32x4 (&Sacc)[2], const bf16_t* R1, const bf16_t* KET, const float* DEC, const bf16_t* PG, bf16_t* O,
                                          int b, int h, int j0, int c, int tid, int wave, int fr, int fq) {
    constexpr int OFF_VT = 0, OFF_SB = 2304, OFF_OST = 2304 + 8704;
    const int row0 = b * SEQ + c * 64;
    GlaRegs cur_r = r;
    if (tid < 128) { const int t = tid >> 1, hf = tid & 1; LAS unsigned short* vt = (LAS unsigned short*)(lds + OFF_VT);
#pragma unroll
        for (int e = 0; e < 4; ++e) { vt[(8 * hf + 2 * e) * 72 + t] = (unsigned short)(cur_r.rv[e] & 0xffffu); vt[(8 * hf + 2 * e + 1) * 72 + t] = (unsigned short)(cur_r.rv[e] >> 16); } }
    if (c > 0) { const unsigned ov = *(const LAS unsigned*)(lds + OFF_OST + tid * 4);
        *(unsigned*)(O + (size_t)(row0 - 64 + (tid >> 3)) * D + h * 256 + j0 + 2 * (tid & 7)) = ov; }
    if (c + 2 < 64) gla_load(r, R1, KET, DEC, PG, b, h, j0, c + 2, tid, wave, fr, fq);
    GLA_BAR();
    const int cur = c & 1;
    const bf16x8 bv0 = *(const LAS bf16x8*)(lds + OFF_VT + fr * 144 + (8 * fq) * 2), bv1 = *(const LAS bf16x8*)(lds + OFF_VT + fr * 144 + (32 + 8 * fq) * 2);
    if (wave < 4) { f32x4 o = {0.f, 0.f, 0.f, 0.f}, o2 = {0.f, 0.f, 0.f, 0.f};
        o = __builtin_amdgcn_mfma_f32_16x16x32_bf16(__builtin_bit_cast(bf16x8, cur_r.f[0]), bv0, o, 0, 0, 0);
        o = __builtin_amdgcn_mfma_f32_16x16x32_bf16(__builtin_bit_cast(bf16x8, cur_r.f[1]), bv1, o, 0, 0, 0);
#pragma unroll
        for (int ks = 0; ks < 4; ++ks) { const bf16x8 sv = *(const LAS bf16x8*)(lds + OFF_SB + cur * (16 * 272) + fr * 272 + (32 * ks + 8 * fq) * 2);
            o2 = __builtin_amdgcn_mfma_f32_16x16x32_bf16(__builtin_bit_cast(bf16x8, cur_r.f[2 + ks]), sv, o2, 0, 0, 0); }
        o = o + o2;
#pragma unroll
        for (int i = 0; i < 4; ++i) { const int t = 16 * wave + 4 * fq + i; ((LAS unsigned short*)(lds + OFF_OST))[t * 16 + fr] = (unsigned short)f2bf(o[i]); }
    } else {
#pragma unroll
        for (int q = 0; q < 2; ++q) { const int dt = 2 * (wave - 4) + q; f32x4 sa = Sacc[q] * __builtin_bit_cast(f32x4, cur_r.f[4 + q]);
            sa = __builtin_amdgcn_mfma_f32_16x16x32_bf16(__builtin_bit_cast(bf16x8, cur_r.f[2 * q]), bv0, sa, 0, 0, 0);
            sa = __builtin_amdgcn_mfma_f32_16x16x32_bf16(__builtin_bit_cast(bf16x8, cur_r.f[2 * q + 1]), bv1, sa, 0, 0, 0);
            Sacc[q] = sa;
            *(LAS u32x2*)(lds + OFF_SB + (cur ^ 1) * (16 * 272) + fr * 272 + (16 * dt + 4 * fq) * 2) = (u32x2){pk2(sa[0], sa[1]), pk2(sa[2], sa[3])}; }
    }
    GLA_BAR();
}
__device__ __forceinline__ void gla_main(LAS unsigned char* lds, const bf16_t* R1, const bf16_t* KET, const float* DEC, const bf16_t* PG, bf16_t* O, int G, int tid, int wave, int lane) {
    constexpr int OFF_SB = 2304, OFF_OST = 2304 + 8704;
    const int fr = lane & 15, fq = lane >> 4;
    for (int unit = blockIdx.x; unit < 256; unit += G) {
        const int xcd_ = unit & 7, idx_ = unit >> 3;
        const int bh = xcd_ * 2 + (idx_ >> 4), s = idx_ & 15, b = bh >> 2, h = bh & 3, j0 = s * 16;
        for (int i = tid; i < 2 * 16 * 272 / 4; i += NTHR) ((LAS unsigned*)(lds + OFF_SB))[i] = 0u;
        f32x4 Sacc[2]; Sacc[0] = (f32x4){0.f, 0.f, 0.f, 0.f}; Sacc[1] = Sacc[0];
        GlaRegs ra, rb;
        gla_load(ra, R1, KET, DEC, PG, b, h, j0, 0, tid, wave, fr, fq); gla_load(rb, R1, KET, DEC, PG, b, h, j0, 1, tid, wave, fr, fq);
        for (int c = 0; c < 64; c += 2) {
            gla_chunk(lds, ra, Sacc, R1, KET, DEC, PG, O, b, h, j0, c, tid, wave, fr, fq);
            gla_chunk(lds, rb, Sacc, R1, KET, DEC, PG, O, b, h, j0, c + 1, tid, wave, fr, fq);
        }
        { const unsigned ov = *(const LAS unsigned*)(lds + OFF_OST + tid * 4);
          *(unsigned*)(O + (size_t)(b * SEQ + 63 * 64 + (tid >> 3)) * D + h * 256 + j0 + 2 * (tid & 7)) = ov; }
        GLA_BAR();
    }
}

__device__ __forceinline__ void gla_post(const Args& a, const bf16_t* O, const bf16_t* R1, bf16_t* AAB, int gw, int NGW, int lane) {
    const f32x4 gw4 = *(const f32x4*)(a.gla_norm_w + 4 * lane);
    for (int row = gw; row < M; row += NGW) {
#pragma unroll
        for (int h = 0; h < 4; ++h) {
            const u32x2 ov = *(const u32x2*)(O + (size_t)row * D + h * 256 + 4 * lane);
            const u32x2 gv = *(const u32x2*)(R1 + (size_t)row * 3072 + 2048 + h * 256 + 4 * lane);
            const float o0 = bflo(ov.x), o1 = bfhi(ov.x), o2 = bflo(ov.y), o3 = bfhi(ov.y);
            const float rstd = 1.0f / sqrtf(wave_sum((o0 * o0 + o1 * o1) + (o2 * o2 + o3 * o3)) * (1.0f / 256.0f) + EPS);
            const float g0 = bflo(gv.x), g1 = bfhi(gv.x), g2 = bflo(gv.y), g3 = bfhi(gv.y);
            u32x2 w; w.x = pk2(o0 * rstd * gw4.x * (g0 * sigmoidf_(g0)), o1 * rstd * gw4.y * (g1 * sigmoidf_(g1)));
            w.y = pk2(o2 * rstd * gw4.z * (g2 * sigmoidf_(g2)), o3 * rstd * gw4.w * (g3 * sigmoidf_(g3)));
            *(u32x2*)(AAB + (size_t)row * 2048 + h * 256 + 4 * lane) = w;
        }
    }
}

__device__ __forceinline__ void conv_phase(const Args& a, const bf16_t* R2, bf16_t* AAB, int gw, int NGW, int lane) {
    const int ch = 16 * lane;
    float w0[16], w1[16], w2[16];
#pragma unroll
    for (int q = 0; q < 4; ++q) { const f32x4 x0 = *(const f32x4*)(a.conv_w + 0 * D + ch + 4 * q), x1 = *(const f32x4*)(a.conv_w + 1 * D + ch + 4 * q), x2 = *(const f32x4*)(a.conv_w + 2 * D + ch + 4 * q);
#pragma unroll
        for (int e = 0; e < 4; ++e) { w0[4 * q + e] = x0[e]; w1[4 * q + e] = x1[e]; w2[4 * q + e] = x2[e]; } }
    for (int rr = gw; rr < M / 8; rr += NGW) {
        const int t0 = rr * 8;
        u32x4 um2[2], um1[2];
        if ((t0 & (SEQ - 1)) == 0) { um2[0] = um2[1] = um1[0] = um1[1] = (u32x4){0u, 0u, 0u, 0u}; }
        else { const bf16_t* p2 = R2 + (size_t)(t0 - 2) * 4096 + 1024 + ch; const bf16_t* p1 = p2 + 4096;
            um2[0] = *(const u32x4*)p2; um2[1] = *(const u32x4*)(p2 + 8); um1[0] = *(const u32x4*)p1; um1[1] = *(const u32x4*)(p1 + 8); }
#pragma unroll
        for (int i = 0; i < 8; ++i) {
            const bf16_t* rp = R2 + (size_t)(t0 + i) * 4096;
            u32x4 u0[2], cb[2]; u0[0] = *(const u32x4*)(rp + 1024 + ch); u0[1] = *(const u32x4*)(rp + 1024 + ch + 8); cb[0] = *(const u32x4*)(rp + ch); cb[1] = *(const u32x4*)(rp + ch + 8);
            u32x4 ow[2];
#pragma unroll
            for (int hv = 0; hv < 2; ++hv)
#pragma unroll
                for (int q = 0; q < 4; ++q) { const int e = 8 * hv + 2 * q;
                    const float y0 = w0[e] * bflo(um2[hv][q]) + w1[e] * bflo(um1[hv][q]) + w2[e] * bflo(u0[hv][q]);
                    const float y1 = w0[e + 1] * bfhi(um2[hv][q]) + w1[e + 1] * bfhi(um1[hv][q]) + w2[e + 1] * bfhi(u0[hv][q]);
                    ow[hv][q] = pk2(bflo(cb[hv][q]) * y0, bfhi(cb[hv][q]) * y1); }
            bf16_t* op = AAB + (size_t)(t0 + i) * 2048 + 1024 + ch;
            *(u32x4*)op = ow[0]; *(u32x4*)(op + 8) = ow[1];
            um2[0] = um1[0]; um2[1] = um1[1]; um1[0] = u0[0]; um1[1] = u0[1];
        }
    }
}

__device__ __forceinline__ void final_norm(const Args& a, float* X, int gw, int NGW, int lane) {
    f32x4 w[4];
#pragma unroll
    for (int j = 0; j < 4; ++j) w[j] = *(const f32x4*)(a.final_norm_w + 4 * lane + 256 * j);
    for (int row = gw; row < M; row += NGW) {
        f32x4* xr = (f32x4*)(X + (size_t)row * D) + lane;
        f32x4 v[4]; float ss = 0.f;
#pragma unroll
        for (int j = 0; j < 4; ++j) { v[j] = xr[64 * j]; ss += (v[j].x * v[j].x + v[j].y * v[j].y) + (v[j].z * v[j].z + v[j].w * v[j].w); }
        const float rstd = 1.0f / sqrtf(wave_sum(ss) * (1.0f / D) + EPS);
#pragma unroll
        for (int j = 0; j < 4; ++j) xr[64 * j] = v[j] * rstd * w[j];
    }
}

__global__ void __launch_bounds__(NTHR, 2) fwd_megakernel(Args a) {
    extern __shared__ __attribute__((aligned(16))) unsigned char lds_raw[];
    LAS unsigned char* lds = (LAS unsigned char*)lds_raw;
    cg::grid_group grid = cg::this_grid();
    const int tid = threadIdx.x, lane = tid & 63, wave = __builtin_amdgcn_readfirstlane(tid >> 6);
    const int G = gridDim.x, gw = blockIdx.x * NWAVES + wave, NGW = G * NWAVES;
    unsigned char* ws = a.ws;
    float* mod = (float*)(ws + WS_MOD);
    bf16_t* W1A = (bf16_t*)(ws + WS_W1A); bf16_t* W1B = (bf16_t*)(ws + WS_W1B); bf16_t* WAB = (bf16_t*)(ws + WS_WAB);
    bf16_t* WOUT = (bf16_t*)(ws + WS_WOUT); bf16_t* WM1 = (bf16_t*)(ws + WS_WM1); bf16_t* WM2 = (bf16_t*)(ws + WS_WM2);
    float* LR = (float*)(ws + WS_LR); float* DEC = (float*)(ws + WS_DEC);
    bf16_t* R = (bf16_t*)(ws + WS_R); bf16_t* KET = (bf16_t*)(ws + WS_KET); bf16_t* PG = (bf16_t*)(ws + WS_KET + 16 * MiB); bf16_t* AAB = (bf16_t*)(ws + WS_AAB);
    bf16_t* Hb = (bf16_t*)a.out; bf16_t* Ob = (bf16_t*)((unsigned char*)a.out + 32 * MiB);
    const int lo = a.ph_lo, hi = a.ph_hi;
    volatile LAS unsigned* bst = (volatile LAS unsigned*)(lds + 140000);
    if (tid < 2) bst[tid] = 0u;
    __syncthreads();
    const XcdBarrier bar = xcd_barrier_post((unsigned*)(ws + WS_BAR), bst);
    if (hi > 1000) grid.sync();
#ifndef PHASE_MASK
#define PHASE_MASK 0xffff
#endif
#define IN(k) (((PHASE_MASK >> (k)) & 1) && lo <= (k) && (k) < hi)
#ifndef PROBE_MASK
#define PROBE_MASK 0
#endif
#define REPS(k) for (int rep_ = 0; rep_ < (((PROBE_MASK >> (k)) & 1) ? 2 : 1); ++rep_)
#define SEAM(k) do { if (IN(k) && IN((k) + 1)) xcd_barrier(bar); } while (0)

    if (IN(0)) { p0_mod(a, mod, gw, NGW, lane); REPS(0) p0_weights(a, lds, gw, NGW, wave, lane); }
    SEAM(0);
    if (IN(1)) REPS(1) { norm_mod_rows<true>(a, lds, a.x, a.norm1_w, mod, 0, D, Hb, LR, G, tid, wave, lane); __syncthreads(); }
    SEAM(1);
    if (IN(2)) REPS(2) { pg8::Gemm g{Hb, W1A, M, 3072, D, D}; pg8::StaticOrder S; S.init(M, 3072, G, (int)blockIdx.x);
        pg8::EpiBf16<0> E{R, 3072}; pg8::gemm_phase<pg8::EpiBf16<0>, pg8::StaticOrder, true, true>(lds, g, S, E); }
    SEAM(2);
    if (IN(3)) gla_prep(a, lds, R, KET, DEC, PG, LR, G, tid, wave, lane);
    SEAM(3);
    if (IN(4)) REPS(4) gla_main(lds, R, KET, DEC, PG, Ob, G, tid, wave, lane);
    SEAM(4);
    if (IN(5)) REPS(5) gla_post(a, Ob, R, AAB, gw, NGW, lane);
    SEAM(5);
    if (IN(6)) REPS(6) { pg8::Gemm g{Hb, W1B, M, 5120, D, D}; pg8::StaticOrder S; S.init(M, 5120, G, (int)blockIdx.x);
        pg8::EpiG1b E{R, 4096}; pg8::gemm_phase<pg8::EpiG1b, pg8::StaticOrder, true, true>(lds, g, S, E); }
    SEAM(6);
    if (IN(7)) REPS(7) conv_phase(a, R, AAB, gw, NGW, lane);
    SEAM(7);
    if (IN(8)) REPS(8) { pg8::Gemm g{AAB, WAB, M, D, 2 * D, 2 * D}; pg8::StaticOrder S; S.init(M, D, G, (int)blockIdx.x);
        pg8::EpiZ E{R + 2048, R + 3072, 4096, R + 1024, 4096}; pg8::gemm_phase<pg8::EpiZ, pg8::StaticOrder, false, true>(lds, g, S, E); }
    SEAM(8);
    if (IN(9)) REPS(9) { pg8::Gemm g{R + 1024, WOUT, M, D, D, 4096}; pg8::StaticOrder S; S.init(M, D, G, (int)blockIdx.x);
        pg8::EpiRes E{a.x, a.out, D, mod + 2 * D}; pg8::gemm_phase<pg8::EpiRes, pg8::StaticOrder, false, true>(lds, g, S, E); }
    SEAM(9);
    if (IN(10)) REPS(10) norm_mod_rows<false>(a, lds, a.out, a.norm2_w, mod, 3 * D, 4 * D, AAB, nullptr, G, tid, wave, lane);
    SEAM(10);
    if (IN(11)) REPS(11) { pg8::Gemm g{AAB, WM1, M, FF, D, D}; pg8::StaticOrder S; S.init(M, FF, G, (int)blockIdx.x);
        pg8::EpiBf16<1> E{R, FF}; pg8::gemm_phase<pg8::EpiBf16<1>, pg8::StaticOrder, true, true>(lds, g, S, E); }
    SEAM(11);
    if (IN(12)) { pg8::Gemm g{R, WM2, M, D, FF, FF}; pg8::StaticOrder S; S.init(M, D, G, (int)blockIdx.x);
        pg8::EpiRes E{a.out, a.out, D, mod + 5 * D}; pg8::gemm_phase<pg8::EpiRes, pg8::StaticOrder, false, true>(lds, g, S, E); }
    SEAM(12);
    if (IN(13)) final_norm(a, a.out, gw, NGW, lane);
#undef IN
#undef SEAM
}

extern "C" void kernel_launch(void* const* d_in, const int* in_sizes, int n_in, void* d_out, int out_size, void* d_ws, size_t ws_size, hipStream_t stream) {
    static int grid = 0;
    if (grid == 0) {
        if (n_in != 17 || in_sizes[0] != M * D || out_size != M * D || ws_size < WS_END) { fprintf(stderr, "kernel_launch: unexpected shapes (n_in %d, in0 %d, out %d, ws %zu)\n", n_in, n_in > 0 ? in_sizes[0] : -1, out_size, ws_size); grid = -1; return; }
        int dev = 0, cus = 0, per_cu = 0;
        if (hipGetDevice(&dev) != hipSuccess || hipDeviceGetAttribute(&cus, hipDeviceAttributeMultiprocessorCount, dev) != hipSuccess) { grid = -1; return; }
        if (hipFuncSetAttribute((const void*)fwd_megakernel, hipFuncAttributeMaxDynamicSharedMemorySize, LDS_BYTES) != hipSuccess) { fprintf(stderr, "kernel_launch: hipFuncSetAttribute failed\n"); grid = -1; return; }
        if (hipOccupancyMaxActiveBlocksPerMultiprocessor(&per_cu, (const void*)fwd_megakernel, NTHR, LDS_BYTES) != hipSuccess || per_cu < 1) { fprintf(stderr, "kernel_launch: occupancy query says %d\n", per_cu); per_cu = 1; }
        (void)hipGetLastError();
        grid = cus;
    }
    if (grid < 0) return;
    if (hipMemsetAsync((char*)d_ws + WS_CTL, 0, CTL_ZERO_BYTES, stream) != hipSuccess) { fprintf(stderr, "kernel_launch: memset failed\n"); return; }
    Args a{};
    const float** pp = (const float**)&a;
    for (int i = 0; i < 17; ++i) pp[i] = (const float*)d_in[i];
    a.out = (float*)d_out; a.ws = (unsigned char*)d_ws; a.ph_lo = 0; a.ph_hi = 14;
    void* args[] = {&a};
    hipError_t e = hipLaunchCooperativeKernel((const void*)fwd_megakernel, dim3(grid), dim3(NTHR), args, LDS_BYTES, stream);
    if (e != hipSuccess) fprintf(stderr, "kernel_launch: cooperative launch failed: %s (grid %d)\n", hipGetErrorString(e), grid);
}
```
